# Optimizing an MI355X kernel written in HIP

```python
import math
import jax, jax.numpy as jnp
from jax import lax
import numpy as np

D_MODEL = 1024
BATCH = 8
SEQ = 2048
DEPTH = 2

CHUNK = 64
D_CONV = 1024
CONV_GROUPS = 16
CONV_WIDTH = 3
D_SSM = 512
SSM_GROUP = 16
N_SSM_GROUPS = D_SSM // SSM_GROUP
SSM_STATE = 64
N_BRANCH = 2
PROJ_WIDTH = 3 * D_CONV + D_SSM + N_BRANCH * D_MODEL
D_FF = 7 * D_MODEL // 2
N_EXPERTS = 8
TOP_K = 2
N_DENSE = (DEPTH + 1) // 2
N_MOE = DEPTH // 2
RMS_EPS = 1e-6
DT_MIN = 1e-3
DT_MAX = 1e-1

kernel_name = "hybrid_conv_s5_moe_encoder"


def rmsnorm(x, g):
    xf = x.astype(jnp.float32)
    y = xf * lax.rsqrt(jnp.mean(xf * xf, axis=-1, keepdims=True) + RMS_EPS)
    return (y * g.astype(jnp.float32)).astype(x.dtype)


def short_conv_branch(b_gate, c_gate, v, conv_w, w_out):
    u = c_gate * v
    rhs = conv_w.reshape(CONV_WIDTH, 1, D_CONV).astype(u.dtype)
    conv = lax.conv_general_dilated(
        u, rhs, window_strides=(1,), padding=[(CONV_WIDTH - 1, 0)],
        dimension_numbers=("NWC", "WIO", "NWC"), feature_group_count=D_CONV)
    return (b_gate * conv) @ w_out


def _ssm_combine(e_i, e_j):
    ar_i, ai_i, br_i, bi_i = e_i
    ar_j, ai_j, br_j, bi_j = e_j
    return (ar_j * ar_i - ai_j * ai_i,
            ar_j * ai_i + ai_j * ar_i,
            ar_j * br_i - ai_j * bi_i + br_j,
            ar_j * bi_i + ai_j * br_i + bi_j)


def s5_branch(u, a_re, a_im, log_dt, b_re, b_im, c_re, c_im, d_skip, w_glu):
    bsz, seq, _ = u.shape
    f32 = jnp.float32
    uf = u.astype(f32).reshape(bsz, seq, N_SSM_GROUPS, SSM_GROUP)
    ar = a_re.astype(f32)
    ai = a_im.astype(f32)
    dt = jnp.exp(log_dt.astype(f32))[:, None]
    mag = jnp.exp(ar * dt)
    abar_re = mag * jnp.cos(ai * dt)
    abar_im = mag * jnp.sin(ai * dt)
    den = ar * ar + ai * ai
    nr = abar_re - 1.0
    ni = abar_im
    coef_re = (nr * ar + ni * ai) / den
    coef_im = (ni * ar - nr * ai) / den
    br = b_re.astype(f32)
    bi = b_im.astype(f32)
    bb_re = coef_re[..., None] * br - coef_im[..., None] * bi
    bb_im = coef_re[..., None] * bi + coef_im[..., None] * br
    bu_re = jnp.einsum("blgc,gnc->lbgn", uf, bb_re)
    bu_im = jnp.einsum("blgc,gnc->lbgn", uf, bb_im)
    a_seq_re = jnp.broadcast_to(abar_re, (seq, 1, N_SSM_GROUPS, SSM_STATE))
    a_seq_im = jnp.broadcast_to(abar_im, (seq, 1, N_SSM_GROUPS, SSM_STATE))
    _, _, s_re, s_im = lax.associative_scan(
        _ssm_combine, (a_seq_re, a_seq_im, bu_re, bu_im), axis=0)
    y = (jnp.einsum("gcn,lbgn->blgc", c_re.astype(f32), s_re)
         - jnp.einsum("gcn,lbgn->blgc", c_im.astype(f32), s_im))
    y = y.reshape(bsz, seq, D_SSM) + d_skip.astype(f32) * u.astype(f32)
    y = jax.nn.gelu(y).astype(u.dtype)
    z = y @ w_glu
    return z[..., :D_MODEL] * jax.nn.sigmoid(z[..., D_MODEL:])


def swiglu(h, w_gate, w_up, w_down):
    return (jax.nn.silu(h @ w_gate) * (h @ w_up)) @ w_down


def moe_swiglu(h, router_w, router_b, w_gate, w_up, w_down):
    logits = (h @ router_w).astype(jnp.float32) + router_b.astype(jnp.float32)
    top_val, top_idx = lax.top_k(logits, TOP_K)
    top_w = jax.nn.softmax(top_val, axis=-1)
    gate = jnp.sum(jax.nn.one_hot(top_idx, N_EXPERTS, dtype=jnp.float32) * top_w[..., None],
                   axis=-2).astype(h.dtype)
    out = jnp.zeros_like(h)
    for e in range(N_EXPERTS):
        out = out + gate[..., e:e + 1] * swiglu(h, w_gate[e], w_up[e], w_down[e])
    return out


def setup_inputs(seed: int = 0) -> dict:
    key = jax.random.key(seed)
    ks = jax.random.split(key, 32)
    f32 = jnp.float32
    nrm = lambda k, shape, scale: jax.random.normal(k, shape, f32) * scale
    n_idx = jnp.arange(SSM_STATE, dtype=f32)
    ssm_a_re = -0.5 + nrm(ks[5], (DEPTH, N_SSM_GROUPS, SSM_STATE), 0.01)
    ssm_a_im = math.pi * n_idx + nrm(ks[6], (DEPTH, N_SSM_GROUPS, SSM_STATE), 0.01)
    ssm_log_dt = jax.random.uniform(ks[7], (DEPTH, N_SSM_GROUPS), f32,
                                    math.log(DT_MIN), math.log(DT_MAX))
    return {
        "x": nrm(ks[0], (BATCH, SEQ, D_MODEL), 1.0),
        "norm_mix": 1.0 + nrm(ks[1], (DEPTH, D_MODEL), 0.02),
        "w_in": nrm(ks[2], (DEPTH, D_MODEL, PROJ_WIDTH), D_MODEL ** -0.5),
        "b_in": nrm(ks[3], (DEPTH, PROJ_WIDTH), 0.02),
        "conv_w": nrm(ks[4], (DEPTH, CONV_WIDTH, D_CONV), CONV_WIDTH ** -0.5),
        "w_conv_out": nrm(ks[8], (DEPTH, D_CONV, D_MODEL), D_CONV ** -0.5),
        "ssm_a_re": ssm_a_re,
        "ssm_a_im": ssm_a_im,
        "ssm_log_dt": ssm_log_dt,
        "ssm_b_re": nrm(ks[9], (DEPTH, N_SSM_GROUPS, SSM_STATE, SSM_GROUP), (2 * SSM_GROUP) ** -0.5),
        "ssm_b_im": nrm(ks[10], (DEPTH, N_SSM_GROUPS, SSM_STATE, SSM_GROUP), (2 * SSM_GROUP) ** -0.5),
        "ssm_c_re": nrm(ks[11], (DEPTH, N_SSM_GROUPS, SSM_GROUP, SSM_STATE), SSM_STATE ** -0.5),
        "ssm_c_im": nrm(ks[12], (DEPTH, N_SSM_GROUPS, SSM_GROUP, SSM_STATE), SSM_STATE ** -0.5),
        "ssm_d": nrm(ks[13], (DEPTH, D_SSM), 1.0),
        "w_glu": nrm(ks[14], (DEPTH, D_SSM, 2 * D_MODEL), D_SSM ** -0.5),
        "w_o": nrm(ks[15], (DEPTH, D_MODEL, D_MODEL), D_MODEL ** -0.5),
        "norm_ffn": 1.0 + nrm(ks[16], (DEPTH, D_MODEL), 0.02),
        "dense_w_gate": nrm(ks[17], (N_DENSE, D_MODEL, D_FF), D_MODEL ** -0.5),
        "dense_w_up": nrm(ks[18], (N_DENSE, D_MODEL, D_FF), D_MODEL ** -0.5),
        "dense_w_down": nrm(ks[19], (N_DENSE, D_FF, D_MODEL), D_FF ** -0.5),
        "router_w": nrm(ks[20], (N_MOE, D_MODEL, N_EXPERTS), D_MODEL ** -0.5),
        "router_b": nrm(ks[21], (N_MOE, N_EXPERTS), 0.01),
        "moe_w_gate": nrm(ks[22], (N_MOE, N_EXPERTS, D_MODEL, D_FF), D_MODEL ** -0.5),
        "moe_w_up": nrm(ks[23], (N_MOE, N_EXPERTS, D_MODEL, D_FF), D_MODEL ** -0.5),
        "moe_w_down": nrm(ks[24], (N_MOE, N_EXPERTS, D_FF, D_MODEL), D_FF ** -0.5),
        "norm_final": 1.0 + nrm(ks[25], (D_MODEL,), 0.02),
    }


def reference(x, norm_mix, w_in, b_in, conv_w, w_conv_out, ssm_a_re, ssm_a_im, ssm_log_dt,
              ssm_b_re, ssm_b_im, ssm_c_re, ssm_c_im, ssm_d, w_glu, w_o, norm_ffn,
              dense_w_gate, dense_w_up, dense_w_down, router_w, router_b,
              moe_w_gate, moe_w_up, moe_w_down, norm_final):
    o_b = 0
    o_c = o_b + D_CONV
    o_v = o_c + D_CONV
    o_u = o_v + D_CONV
    o_g = o_u + D_SSM
    for layer in range(DEPTH):
        h = rmsnorm(x, norm_mix[layer])
        proj = h @ w_in[layer] + b_in[layer]
        b_gate = proj[..., o_b:o_c]
        c_gate = proj[..., o_c:o_v]
        v = proj[..., o_v:o_u]
        u = proj[..., o_u:o_g]
        g_conv = jax.nn.sigmoid(proj[..., o_g:o_g + D_MODEL])
        g_ssm = jax.nn.sigmoid(proj[..., o_g + D_MODEL:o_g + 2 * D_MODEL])
        y_conv = short_conv_branch(b_gate, c_gate, v, conv_w[layer], w_conv_out[layer])
        y_ssm = s5_branch(u, ssm_a_re[layer], ssm_a_im[layer], ssm_log_dt[layer],
                          ssm_b_re[layer], ssm_b_im[layer], ssm_c_re[layer], ssm_c_im[layer],
                          ssm_d[layer], w_glu[layer])
        x = x + (g_conv * y_conv + g_ssm * y_ssm) @ w_o[layer]
        h = rmsnorm(x, norm_ffn[layer])
        if layer % 2 == 0:
            i = layer // 2
            f = swiglu(h, dense_w_gate[i], dense_w_up[i], dense_w_down[i])
        else:
            i = layer // 2
            f = moe_swiglu(h, router_w[i], router_b[i], moe_w_gate[i], moe_w_up[i], moe_w_down[i])
        x = x + f
    return rmsnorm(x, norm_final)
```

```cpp
#include <hip/hip_runtime.h>
#include <cstdio>
#include <cstdint>

#ifndef MK_PER_PHASE
#define MK_PER_PHASE 0
#endif

constexpr int M = 16384, D = 1024, SEQ = 2048, PW = 5632, DFF = 3584, NE = 8, DSSM = 512;
constexpr int TCH = 32, NCH = M / TCH, NG = 32, KY = 640;
constexpr int MOE_ROWS = 34816, MOE_PANELS = 136;
constexpr float RMS_EPS = 1e-6f;

namespace pg8 {
#define PG8_LAS __attribute__((address_space(3)))
typedef unsigned short bf16_t;
typedef short bf16x8 __attribute__((ext_vector_type(8)));
typedef float f32x4 __attribute__((ext_vector_type(4)));
typedef float f32x2 __attribute__((ext_vector_type(2)));
typedef unsigned u32x4 __attribute__((ext_vector_type(4)));
typedef unsigned u32x2 __attribute__((ext_vector_type(2)));
constexpr int BM = 256, BK = 64, HALF = 128, HTB = HALF * BK * 2, STAGE_BYTES = 8 * HTB, NXCD = 8, WGM = 8;

__host__ __device__ __forceinline__ int lds_byte(int r, int c) { const int st = (r >> 4) * 2 + (c >> 5), rr = r & 15, cc = c & 31, ob = rr * 64 + cc * 2; return st * 1024 + (ob ^ (((ob >> 9) & 1) << 5)); }
__host__ __device__ __forceinline__ void stage_rc(int b, int& R, int& C) { const int st = b / 1024, sb = b % 1024, swz = sb ^ (((sb >> 9) & 1) << 5); R = (st >> 1) * 16 + swz / 64; C = (st & 1) * 32 + (swz % 64) / 2; }
__host__ __device__ __forceinline__ int perm32(int rho) { const int n = rho >> 4, i = rho & 15; return 8 * (i >> 2) + 4 * n + (i & 3); }

struct Unit { int pm, pn, aux; const char* A; const char* B; const int* tok; };

struct Order {
    int nM, nN, nwg, G, c;
    __device__ __forceinline__ void init(int nM_, int nN_, int G_, int c_) { nM = nM_; nN = nN_; nwg = nM * nN; G = G_; c = c_; }
    __device__ __forceinline__ bool tile(int i, int& pm, int& pn) const {
        const long L = (long)i * G + c; if (L >= nwg) return false;
        int wgid = (int)L; { const int q = nwg / NXCD, r = nwg % NXCD, xcd = wgid % NXCD, off = wgid / NXCD; wgid = (xcd < r ? xcd * (q + 1) : r * (q + 1) + (xcd - r) * q) + off; }
        const int nig = WGM * nN, gid = wgid / nig, fm = gid * WGM, gsz = (nM - fm) < WGM ? (nM - fm) : WGM;
        pm = fm + ((wgid % nig) % gsz); pn = (wgid % nig) / gsz; return true;
    }
};

typedef int i32x4 __attribute__((ext_vector_type(4)));
typedef int i32x8 __attribute__((ext_vector_type(8)));
__device__ __forceinline__ i32x8 cat8(bf16x8 a, bf16x8 b) { return __builtin_shufflevector(__builtin_bit_cast(i32x4, a), __builtin_bit_cast(i32x4, b), 0, 1, 2, 3, 4, 5, 6, 7); }
__device__ __forceinline__ unsigned cvt_pk_bf16(float lo, float hi) { unsigned r; asm volatile("v_cvt_pk_bf16_f32 %0, %1, %2" : "=v"(r) : "v"(lo), "v"(hi)); return r; }
__device__ __forceinline__ float bf_lo(unsigned w) { return __uint_as_float(w << 16); }
__device__ __forceinline__ float bf_hi(unsigned w) { return __uint_as_float(w & 0xffff0000u); }
__device__ __forceinline__ float sigmoid_f(float x) { return __builtin_amdgcn_rcpf(1.0f + __builtin_amdgcn_exp2f(-1.4426950408889634f * x)); }
__device__ __forceinline__ float gelu_tanh_f(float x) { const float t = 0.7978845608028654f * (x + 0.044715f * x * x * x); return x * sigmoid_f(2.0f * t); }

template <class Epi, class Sched, bool GATHER = false, bool ALIGN_EPI = true, bool FP8 = false>
__device__ __forceinline__ void gemm_phase(PG8_LAS unsigned char* lds, const int KB  , const unsigned lda, const unsigned ldb, const Sched& S, const Epi& E) {
    int tid_ = threadIdx.x; asm volatile("" : "+v"(tid_));
    const int tid = tid_, wid = __builtin_amdgcn_readfirstlane(tid >> 6), lane = tid & 63, wr = wid >> 2, wc = wid & 3, fr = lane & 15, fq = lane >> 4;
    const int nt = KB / (BK * 2);
    unsigned voffA[2], voffB[2], colA[2]; int rowA[2];
#pragma unroll
    for (int i = 0; i < 2; ++i) { int R, C; stage_rc(tid * 16 + i * 8192, R, C); const int Rb = Epi::PERM ? ((R & ~31) + perm32(R & 31)) : R;
        voffA[i] = (unsigned)R * lda + (unsigned)C * 2u; voffB[i] = (unsigned)Rb * ldb + (unsigned)C * 2u; rowA[i] = R; colA[i] = (unsigned)C * 2u; }
    const size_t kstep = (size_t)(BK * 2);
    const size_t hstepA = (size_t)HALF * lda, hstepB = (size_t)HALF * ldb;
    const unsigned ldsw = (unsigned)wid * 1024u;
    const int aoff = lds_byte(wr * 64 + fr, fq * 8), boff = lds_byte(wc * 32 + fr, fq * 8);
    unsigned gofc[2][2], gofn[2][2];
#define PG8_SA(b, h) (((b) * 2 + (h)) * HTB)
#define PG8_SB(b, h) ((4 + (b) * 2 + (h)) * HTB)
#define PG8_STAGE_B(bufoff, kbase, h) do { _Pragma("unroll") for (int _i = 0; _i < 2; ++_i) \
        __builtin_amdgcn_global_load_lds((const unsigned*)((const char*)(kbase) + (h) * hstepB + voffB[_i]), (PG8_LAS unsigned*)(lds + (bufoff) + ldsw + _i * 8192), 16, 0, 0); } while (0)
#define PG8_STAGE_A(bufoff, kbase, h, NX) do { _Pragma("unroll") for (int _i = 0; _i < 2; ++_i) { \
        const char* _p; if constexpr (GATHER) _p = (const char*)(kbase) + ((NX) ? gofn[h][_i] : gofc[h][_i]); else _p = (const char*)(kbase) + (h) * hstepA + voffA[_i]; \
        __builtin_amdgcn_global_load_lds((const unsigned*)_p, (PG8_LAS unsigned*)(lds + (bufoff) + ldsw + _i * 8192), 16, 0, 0); } } while (0)
#define PG8_LDA(dst, b, h) do { _Pragma("unroll") for (int m = 0; m < 4; ++m) { const bf16x8 _x = *(const PG8_LAS bf16x8*)(lds + PG8_SA(b, h) + aoff + m * 2048), _y = *(const PG8_LAS bf16x8*)(lds + PG8_SA(b, h) + aoff + m * 2048 + 1024); \
        if constexpr (FP8) dst##8[m] = cat8(_x, _y); else { dst[m][0] = _x; dst[m][1] = _y; } } } while (0)
#define PG8_LDB(dst, b, h) do { _Pragma("unroll") for (int n = 0; n < 2; ++n) { const bf16x8 _x = *(const PG8_LAS bf16x8*)(lds + PG8_SB(b, h) + boff + n * 2048), _y = *(const PG8_LAS bf16x8*)(lds + PG8_SB(b, h) + boff + n * 2048 + 1024); \
        if constexpr (FP8) dst##8[n] = cat8(_x, _y); else { dst[n][0] = _x; dst[n][1] = _y; } } } while (0)
#define PG8_MMA(ai, bj, At, Bt) do { __builtin_amdgcn_s_setprio(1); _Pragma("unroll") for (int m = 0; m < 4; ++m) _Pragma("unroll") for (int n = 0; n < 2; ++n) { \
        if constexpr (FP8) asm volatile("v_mfma_f32_16x16x128_f8f6f4 %0, %1, %2, %0" : "+v"(acc[ai][bj][m][n]) : "v"(Bt##8[n]), "v"(At##8[m]));     \
        else { _Pragma("unroll") for (int k = 0; k < 2; ++k) acc[ai][bj][m][n] = __builtin_amdgcn_mfma_f32_16x16x32_bf16(Bt[n][k], At[m][k], acc[ai][bj][m][n], 0, 0, 0); } } __builtin_amdgcn_s_setprio(0); } while (0)
#define PG8_WAIT_V(n) asm volatile("s_waitcnt vmcnt(" #n ")" ::: "memory")
#define PG8_WAIT_VSEL(f) asm volatile("s_cmp_eq_u32 %0, 0\n\ts_cbranch_scc1 1f\n\ts_waitcnt vmcnt(%1)\n\ts_branch 2f\n1:\ts_waitcnt vmcnt(8)\n2:" :: "s"(f), "n"(10 + Epi::NVMEM) : "memory", "scc")
#define PG8_WAIT_L(n) asm volatile("s_waitcnt lgkmcnt(" #n ")" ::: "memory")
#define PG8_BAR __builtin_amdgcn_s_barrier()
#define PG8_SCHED __builtin_amdgcn_sched_barrier(0)
    Unit cur, nxt; int ui = 0;
    if (!S.next(0, cur)) return;
    if constexpr (GATHER) {
#pragma unroll
        for (int h = 0; h < 2; ++h)
#pragma unroll
            for (int i = 0; i < 2; ++i) { gofc[h][i] = (unsigned)cur.tok[rowA[i] + HALF * h] * lda + colA[i]; gofn[h][i] = gofc[h][i]; }
    }
    f32x4 acc[2][2][4][2];
#pragma unroll
    for (int a = 0; a < 2; ++a)
#pragma unroll
        for (int b = 0; b < 2; ++b)
#pragma unroll
            for (int m = 0; m < 4; ++m)
#pragma unroll
                for (int n = 0; n < 2; ++n) acc[a][b][m][n] = (f32x4){0.f, 0.f, 0.f, 0.f};
    bf16x8 At[4][2], B0[2][2], B1[2][2]; i32x8 At8[4], B08[2], B18[2];
    const char* cA = cur.A; const char* cB = cur.B;
    PG8_STAGE_B(PG8_SB(0, 0), cB, 0); PG8_STAGE_B(PG8_SB(0, 1), cB, 1); PG8_STAGE_A(PG8_SA(0, 0), cA, 0, false); PG8_STAGE_A(PG8_SA(0, 1), cA, 1, false);
    if (wr == 1) PG8_BAR;
    PG8_WAIT_V(2); PG8_BAR;
    PG8_STAGE_B(PG8_SB(1, 0), cB + kstep, 0); PG8_STAGE_A(PG8_SA(1, 0), cA + kstep, 0, false); PG8_STAGE_B(PG8_SB(1, 1), cB + kstep, 1);
    PG8_WAIT_V(6); PG8_BAR;
    for (;;) {
        const bool has_next = S.next(ui + 1, nxt);
        const char* nA = has_next ? nxt.A : cA; const char* nB = has_next ? nxt.B : cB;
        for (int t = 0; t < nt; t += 2) {
            const bool last = (t == nt - 2);
            const char* a1 = cA + (size_t)(t + 1) * kstep;
            const char* a2 = last ? nA : cA + (size_t)(t + 2) * kstep; const char* b2 = last ? nB : cB + (size_t)(t + 2) * kstep;
            const char* a3 = a2 + kstep; const char* b3 = b2 + kstep;
            if constexpr (GATHER) { if (last && has_next) {
#pragma unroll
                for (int h = 0; h < 2; ++h)
#pragma unroll
                    for (int i = 0; i < 2; ++i) gofn[h][i] = (unsigned)nxt.tok[rowA[i] + HALF * h] * lda + colA[i]; } }
            const int fa = __builtin_amdgcn_readfirstlane((t == 0 && ui > 0) ? 1 : 0);
            PG8_LDB(B0, 0, 0); PG8_LDB(B1, 0, 1); PG8_SCHED; PG8_LDA(At, 0, 0); PG8_STAGE_A(PG8_SA(1, 1), a1, 1, false);
            PG8_WAIT_VSEL(fa); PG8_WAIT_L(0); PG8_BAR; PG8_MMA(0, 0, At, B0); PG8_MMA(0, 1, At, B1); PG8_BAR; PG8_SCHED;
            PG8_LDA(At, 0, 1); PG8_STAGE_B(PG8_SB(0, 0), b2, 0); PG8_STAGE_B(PG8_SB(0, 1), b2, 1); PG8_STAGE_A(PG8_SA(0, 0), a2, 0, last);
            PG8_WAIT_VSEL(fa); PG8_WAIT_L(0); PG8_BAR; PG8_MMA(1, 0, At, B0); PG8_MMA(1, 1, At, B1); PG8_BAR; PG8_SCHED;
            PG8_LDB(B0, 1, 0); PG8_LDB(B1, 1, 1); PG8_SCHED; PG8_LDA(At, 1, 0); PG8_STAGE_A(PG8_SA(0, 1), a2, 1, last);
            PG8_WAIT_VSEL(fa); PG8_WAIT_L(0); PG8_BAR; PG8_MMA(0, 0, At, B0); PG8_MMA(0, 1, At, B1); PG8_BAR; PG8_SCHED;
            PG8_LDA(At, 1, 1); PG8_STAGE_B(PG8_SB(1, 0), b3, 0); PG8_STAGE_B(PG8_SB(1, 1), b3, 1); PG8_STAGE_A(PG8_SA(1, 0), a3, 0, last);
            PG8_WAIT_V(8); PG8_WAIT_L(0); PG8_BAR; PG8_MMA(1, 0, At, B0); PG8_MMA(1, 1, At, B1); PG8_BAR; PG8_SCHED;
        }
        if constexpr (ALIGN_EPI) { if (wr == 0) PG8_BAR; }
        static_assert(ALIGN_EPI && Epi::NVMEM >= 8 && Epi::NVMEM <= 48, "post-epilogue waits");
        if (has_next) { asm volatile("" ::: "memory"); PG8_STAGE_A(PG8_SA(1, 1), nA + kstep, 1, true); asm volatile("" ::: "memory"); }
        if constexpr (FP8) {
            asm volatile("s_nop 15\n\ts_nop 7" : "+v"(acc[0][0][0][0]), "+v"(acc[0][0][0][1]), "+v"(acc[0][0][1][0]), "+v"(acc[0][0][1][1]), "+v"(acc[0][0][2][0]), "+v"(acc[0][0][2][1]), "+v"(acc[0][0][3][0]), "+v"(acc[0][0][3][1]),
                         "+v"(acc[0][1][0][0]), "+v"(acc[0][1][0][1]), "+v"(acc[0][1][1][0]), "+v"(acc[0][1][1][1]), "+v"(acc[0][1][2][0]), "+v"(acc[0][1][2][1]), "+v"(acc[0][1][3][0]), "+v"(acc[0][1][3][1]));
            asm volatile("" : "+v"(acc[1][0][0][0]), "+v"(acc[1][0][0][1]), "+v"(acc[1][0][1][0]), "+v"(acc[1][0][1][1]), "+v"(acc[1][0][2][0]), "+v"(acc[1][0][2][1]), "+v"(acc[1][0][3][0]), "+v"(acc[1][0][3][1]),
                         "+v"(acc[1][1][0][0]), "+v"(acc[1][1][0][1]), "+v"(acc[1][1][1][0]), "+v"(acc[1][1][1][1]), "+v"(acc[1][1][2][0]), "+v"(acc[1][1][2][1]), "+v"(acc[1][1][3][0]), "+v"(acc[1][1][3][1])); }
        E(acc, cur, wr, wc, fr, fq);
        if (!has_next) break;
#pragma unroll
        for (int a = 0; a < 2; ++a)
#pragma unroll
            for (int b = 0; b < 2; ++b)
#pragma unroll
                for (int m = 0; m < 4; ++m)
#pragma unroll
                    for (int n = 0; n < 2; ++n) acc[a][b][m][n] = (f32x4){0.f, 0.f, 0.f, 0.f};
        cur = nxt; cA = nA; cB = nB; ++ui;
        if constexpr (GATHER) {
#pragma unroll
            for (int h = 0; h < 2; ++h)
#pragma unroll
                for (int i = 0; i < 2; ++i) gofc[h][i] = gofn[h][i];
        }
        if constexpr (ALIGN_EPI) { if (wr == 1) PG8_BAR; }
    }
    PG8_WAIT_V(0);
    if constexpr (!ALIGN_EPI) { if (wr == 0) PG8_BAR; }
    PG8_BAR;
#undef PG8_SA
#undef PG8_SB
#undef PG8_STAGE_A
#undef PG8_STAGE_B
#undef PG8_LDA
#undef PG8_LDB
#undef PG8_MMA
#undef PG8_WAIT_V
#undef PG8_WAIT_VSEL
#undef PG8_WAIT_L
#undef PG8_BAR
#undef PG8_SCHED
}
}

constexpr size_t MiB = 1u << 20;
constexpr size_t WS_CTL = 0, CTL_ZERO_BYTES = 64 * 1024;
constexpr size_t WS_SELE = 1 * MiB;
constexpr size_t WS_SELW = WS_SELE + 64 * 1024;
constexpr size_t WS_CNTG = WS_SELW + 128 * 1024;
constexpr size_t WS_ROWTOK = WS_CNTG + 8 * 1024;
constexpr size_t WS_ROWW = WS_ROWTOK + 160 * 1024;
constexpr size_t WS_TOKPOS = WS_ROWW + 160 * 1024;
constexpr size_t WS_AT = WS_TOKPOS + 128 * 1024;
static_assert(WS_AT + 32 * 1024 <= 4 * MiB, "tables");
constexpr size_t WS_WMGU = 4 * MiB;
constexpr size_t WS_WMD = 60 * MiB;
constexpr size_t WS_HN = 88 * MiB;
constexpr size_t WS_ACT = 120 * MiB;
constexpr size_t WS_BB = WS_ACT;
constexpr size_t WS_UC = WS_ACT + 32 * MiB;
constexpr size_t WS_UB = WS_ACT + 64 * MiB;
constexpr size_t WS_GC = WS_ACT + 84 * MiB;
constexpr size_t WS_GS = WS_ACT + 116 * MiB;
constexpr size_t WS_HID = WS_ACT;
constexpr size_t WS_MOEO = 240 * MiB;
constexpr size_t WS_WDGU = 268 * MiB;
constexpr size_t WS_WDD = 282 * MiB;
constexpr size_t WS_BTY = 289 * MiB;
constexpr size_t WS_BTS = 329 * MiB;
constexpr size_t WS_WIN = 338 * MiB;
constexpr size_t WS_WCO = 360 * MiB, WS_WGLU = 364 * MiB, WS_WO = 368 * MiB;
constexpr size_t WS_XB = 372 * MiB;
constexpr size_t WS_SSQ = 404 * MiB;
constexpr size_t WS_END = 405 * MiB;
static_assert(WS_HID + (size_t)MOE_ROWS * DFF <= WS_MOEO && WS_MOEO + (size_t)MOE_ROWS * D * 2 <= WS_END && WS_GS + 32 * MiB <= WS_WDGU, "map: the MoE buffers overlay the mixer activations and non-MoE weight copies (all dead by then)");
constexpr int CW_BAR = 1024;

constexpr int RING_BYTES = 131072, TAB_OFF = RING_BYTES;
constexpr int T_MISC = TAB_OFF;
constexpr int T_SELE = TAB_OFF + 128;
constexpr int T_SELW = T_SELE + 256;
constexpr int T_PEXP = T_SELW + 512;
constexpr int T_TOT = T_PEXP + 4 * (MOE_PANELS + 8);
constexpr int T_BIAS = 133120;
constexpr int T_RSTD = T_BIAS + 4 * PW;
constexpr int T_RMAP = T_RSTD + 4096;
constexpr int LDS_BYTES = 163840;
static_assert(T_TOT + 128 <= T_BIAS && T_RMAP + 16 <= LDS_BYTES, "LDS map");

#define GAS __attribute__((address_space(1)))
#define LAS __attribute__((address_space(3)))
typedef unsigned short bf16;
typedef unsigned v4u __attribute__((ext_vector_type(4)));
typedef unsigned v2u __attribute__((ext_vector_type(2)));
typedef float f32x4 __attribute__((ext_vector_type(4)));
typedef float f32x2 __attribute__((ext_vector_type(2)));
#define LDS_WAIT() asm volatile("s_waitcnt lgkmcnt(0)" ::: "memory")
using pg8::cvt_pk_bf16; using pg8::bf_lo; using pg8::bf_hi; using pg8::sigmoid_f; using pg8::gelu_tanh_f;

#define XB_TMO      128
#define XB_XCNT(j)  (256  + 64 * (j))
#define XB_XSUB(j)  (1280 + 64 * (j))
#define XB_XGEN(j)  (2304 + 64 * (j))
#define XB_TOP      3328
#define XB_TOPGEN   3392
#define XCD_BAR_WORDS 3456
#define XB_SPIN_CAP (1u << 18)
__device__ __forceinline__ unsigned xb_ld(unsigned* p)              { return __hip_atomic_load(p, __ATOMIC_RELAXED, __HIP_MEMORY_SCOPE_AGENT); }
__device__ __forceinline__ unsigned xb_add(unsigned* p, unsigned v) { return __hip_atomic_fetch_add(p, v, __ATOMIC_RELAXED, __HIP_MEMORY_SCOPE_AGENT); }
__device__ __forceinline__ unsigned xb_xcc_id() { return (unsigned)__builtin_amdgcn_s_getreg((3 << 11) | 20) & 0xFu; }
#define XB_SPIN(cond, bar) do { unsigned _sp = 0; while (cond) { __builtin_amdgcn_s_sleep(1); \
    if ((++_sp & 255u) == 0u) { if (xb_ld(&(bar)[XB_TMO])) break; if (_sp > XB_SPIN_CAP) { atomicAdd(&(bar)[XB_TMO], 1u); break; } } } } while (0)
struct XcdBarrier { unsigned* bar; unsigned x; volatile LAS unsigned* st; };
__device__ __forceinline__ XcdBarrier xcd_barrier_post(unsigned* bar, volatile LAS unsigned* st) {
    XcdBarrier b; b.bar = bar; b.x = xb_xcc_id(); b.st = st;
    if (threadIdx.x == 0) (void)xb_add(&bar[XB_XCNT(b.x)], 1u);
    return b;
}
__device__ __forceinline__ void xcd_barrier_complete(unsigned* bar, unsigned x, unsigned& nloc, unsigned& nx) {
    const unsigned G = gridDim.x * gridDim.y * gridDim.z;
    unsigned sum, cnt, mine, sp = 0u;
    for (;;) {
        sum = 0u; cnt = 0u; mine = 0u;
#pragma unroll
        for (unsigned j = 0; j < 16; ++j) { const unsigned c = xb_ld(&bar[XB_XCNT(j)]); sum += c; cnt += (c > 0u) ? 1u : 0u; mine = (j == x) ? c : mine; }
        if (sum == G) break;
        __builtin_amdgcn_s_sleep(1);
        if ((++sp & 255u) == 0u) { if (xb_ld(&bar[XB_TMO])) break; if (sp > XB_SPIN_CAP) { atomicAdd(&bar[XB_TMO], 1u); break; } }
    }
    nloc = mine > 0u ? mine : 1u; nx = cnt > 0u ? cnt : 1u;
}
__device__ __forceinline__ void xcd_barrier(const XcdBarrier& b) {
    asm volatile("s_waitcnt vmcnt(0)" ::: "memory");
    __syncthreads();
    if (threadIdx.x == 0) {
        unsigned* bar = b.bar;
        __builtin_amdgcn_s_waitcnt(0);
        unsigned nloc = b.st[0], nx = b.st[1];
        if (nloc == 0u) { xcd_barrier_complete(bar, b.x, nloc, nx); b.st[0] = nloc; b.st[1] = nx; }
        const unsigned old = xb_add(&bar[XB_XSUB(b.x)], 1u);
        const unsigned gen = old / nloc;
        if (old + 1u == (gen + 1u) * nloc) {
            __builtin_amdgcn_fence(__ATOMIC_RELEASE, "agent");
            asm volatile("s_waitcnt vmcnt(0)" ::: "memory");
            const unsigned og = xb_add(&bar[XB_TOP], 1u);
            const unsigned tg = og / nx;
            if (og + 1u == (tg + 1u) * nx) xb_add(&bar[XB_TOPGEN], 1u);
            else XB_SPIN(xb_ld(&bar[XB_TOPGEN]) == tg, bar);
            __builtin_amdgcn_fence(__ATOMIC_ACQUIRE, "agent");
            xb_add(&bar[XB_XGEN(b.x)], 1u);
            asm volatile("s_waitcnt vmcnt(0)" ::: "memory");
        } else {
            XB_SPIN(xb_ld(&bar[XB_XGEN(b.x)]) == gen, bar);
            __builtin_amdgcn_fence(__ATOMIC_ACQUIRE, "agent");
            asm volatile("s_waitcnt vmcnt(0)" ::: "memory");
        }
    }
    __syncthreads();
}

struct Frame {
    LAS unsigned char* lds;
    int tid, lane, wave, bid, vcu, G;
    unsigned char* ws;
};
typedef const void* kcvp_t;
__device__ __forceinline__ const void* karg_ptr(int off) { const __attribute__((address_space(4))) char* b = (const __attribute__((address_space(4))) char*)__builtin_amdgcn_kernarg_segment_ptr(); asm volatile("" : "+s"(b)); return *(const __attribute__((address_space(4))) kcvp_t*)(b + off); }
#define KIN(i) ((const float*)karg_ptr(8 * (i)))
#define KOUT ((float*)karg_ptr(208))
#define KWS ((unsigned char*)karg_ptr(216))
#define MKFRAME(F) Frame F; { int t_ = threadIdx.x; asm volatile("" : "+v"(t_)); F.lds = (LAS unsigned char*)lds_raw; F.tid = t_; F.lane = t_ & 63; F.wave = __builtin_amdgcn_readfirstlane(t_ >> 6); \
    { int g_ = gridDim.x, b_ = blockIdx.x; asm volatile("" : "+s"(g_), "+s"(b_)); F.G = g_; F.bid = b_; } F.vcu = (F.G % 8 == 0) ? (F.bid % 8) * (F.G / 8) + F.bid / 8 : F.bid; F.ws = KWS; }

__device__ __forceinline__ float wave_sum(float v) {
#pragma unroll
    for (int o = 1; o < 64; o <<= 1) v += __shfl_xor(v, o);
    return v;
}

__device__ __forceinline__ void prep_rstd(Frame& F, const pg8::Order& o, const float* SSQ) {
    LAS int* map = (LAS int*)(F.lds + T_RMAP); LAS float* rl = (LAS float*)(F.lds + T_RSTD);
    int p0 = -1, p1 = -1, p2 = -1, p3 = -1, np = 0;
    for (int i = 0; ; ++i) { int pm, pn; if (!o.tile(i, pm, pn)) break;
        if (pm == p0 || pm == p1 || pm == p2 || pm == p3) continue;
        if (np == 0) p0 = pm; else if (np == 1) p1 = pm; else if (np == 2) p2 = pm; else if (np == 3) p3 = pm;
        ++np; }
    if (F.tid == 0) { map[0] = p0; map[1] = p1; map[2] = p2; map[3] = p3; }
#pragma unroll
    for (int it = 0; it < 2; ++it) { const int sl = 2 * it + (F.tid >> 8); const int ps = sl == 0 ? p0 : sl == 1 ? p1 : sl == 2 ? p2 : p3;
        if (ps >= 0) { const int t = F.tid & 255; const f32x4* p = (const f32x4*)(SSQ + (size_t)(ps * 256 + t) * 16); const f32x4 a = p[0], b = p[1], c = p[2], d = p[3];
            const float q = ((a[0] + a[1]) + (a[2] + a[3])) + ((b[0] + b[1]) + (b[2] + b[3])) + ((c[0] + c[1]) + (c[2] + c[3])) + ((d[0] + d[1]) + (d[2] + d[3]));
            rl[sl * 256 + t] = 1.0f / sqrtf(q * (1.0f / D) + RMS_EPS); } }
    __syncthreads();
}
__device__ __forceinline__ void prep_bias(Frame& F, const float* bias) {
    LAS float* bl = (LAS float*)(F.lds + T_BIAS);
    for (int i = F.tid; i < PW; i += 512) bl[i] = bias[i];
    __syncthreads();
}
struct SchedPlain {
    pg8::Order o; const char* A; const char* B; size_t tA, tB;
    __device__ __forceinline__ bool next(int i, pg8::Unit& u) const { int pm, pn; if (!o.tile(i, pm, pn)) return false; u.pm = pm; u.pn = pn; u.aux = 0; u.A = A + (size_t)pm * tA; u.B = B + (size_t)pn * tB; u.tok = nullptr; return true; }
};
struct SchedSsmY {
    pg8::Order o; const char* UB; const char* BTY;
    __device__ __forceinline__ bool next(int i, pg8::Unit& u) const { int pm, pnn; if (!o.tile(i, pm, pnn)) return false; const int g = pnn >> 1; u.pm = pm; u.pn = pnn & 1; u.aux = g;
        u.A = UB + (size_t)pm * 256 * (NG * KY * 2) + (size_t)g * (KY * 2); u.B = BTY + (size_t)pnn * 256 * (KY * 2); u.tok = nullptr; return true; }
};
struct SchedSsmS {
    pg8::Order o; const char* UB; const char* BTS;
    __device__ __forceinline__ bool next(int i, pg8::Unit& u) const { int pm, g; if (!o.tile(i, pm, g)) return false; u.pm = pm; u.pn = 0; u.aux = g;
        u.A = UB + (size_t)pm * 256 * (NG * KY * 2) + (size_t)g * (KY * 2); u.B = BTS + (size_t)g * 128 * (512 * 2); u.tok = nullptr; return true; }
};
struct SchedMoe1 {
    pg8::Order o; const char* HN; const char* W; const int* rowtok; const LAS int* pexp;
    __device__ __forceinline__ bool next(int i, pg8::Unit& u) const { int pm, pn; if (!o.tile(i, pm, pn)) return false; const int e = pexp[pm]; u.pm = pm; u.pn = pn; u.aux = e;
        u.A = HN; u.B = W + (size_t)e * (2 * DFF) * D + (size_t)pn * 256 * D; u.tok = rowtok + pm * 256; return true; }
};
struct SchedMoe2 {
    pg8::Order o; const char* HID; const char* W; const LAS int* pexp;
    __device__ __forceinline__ bool next(int i, pg8::Unit& u) const { int pm, pn; if (!o.tile(i, pm, pn)) return false; const int e = pexp[pm]; u.pm = pm; u.pn = pn; u.aux = e;
        u.A = HID + (size_t)pm * 256 * DFF; u.B = W + (size_t)e * D * DFF + (size_t)pn * 256 * DFF; u.tok = nullptr; return true; }
};

using pg8::Unit; using pg8::HALF; using pg8::BM;
typedef const f32x4 (&AccRef)[2][2][4][2];
constexpr int HN_SH = 4, WGU_SH = 7, HID_SH = 3, WD_SH = 8;
__device__ __forceinline__ float clamp8(float v) { return __builtin_fminf(__builtin_fmaxf(v, -440.0f), 440.0f); }
__device__ __forceinline__ unsigned pk4_fp8(float a, float b, float c, float d) { unsigned w = 0u; w = (unsigned)__builtin_amdgcn_cvt_pk_fp8_f32(a, b, (int)w, false); w = (unsigned)__builtin_amdgcn_cvt_pk_fp8_f32(c, d, (int)w, true); return w; }
__device__ __forceinline__ v4u pack8(const f32x4 a, const f32x4 b) { v4u w; w.x = cvt_pk_bf16(a[0], a[1]); w.y = cvt_pk_bf16(a[2], a[3]); w.z = cvt_pk_bf16(b[0], b[1]); w.w = cvt_pk_bf16(b[2], b[3]); return w; }
__device__ __forceinline__ void unpack8(const v4u w, f32x4& a, f32x4& b) { a = (f32x4){bf_lo(w.x), bf_hi(w.x), bf_lo(w.y), bf_hi(w.y)}; b = (f32x4){bf_lo(w.z), bf_hi(w.z), bf_lo(w.w), bf_hi(w.w)}; }

__device__ __forceinline__ void row_rstd(const float* SSQ, const LAS unsigned char* lds, int pm, int rloc, float (&rs)[2][4]) {
    const LAS int* map = (const LAS int*)(lds + T_RMAP); const LAS float* rl = (const LAS float*)(lds + T_RSTD);
    const int sl = map[0] == pm ? 0 : map[1] == pm ? 1 : map[2] == pm ? 2 : map[3] == pm ? 3 : -1;
    if (sl >= 0) {
#pragma unroll
        for (int ai = 0; ai < 2; ++ai)
#pragma unroll
            for (int m = 0; m < 4; ++m) rs[ai][m] = rl[sl * 256 + rloc + ai * HALF + m * 16];
    } else {
#pragma unroll
        for (int ai = 0; ai < 2; ++ai)
#pragma unroll
            for (int m = 0; m < 4; ++m) { const f32x4* p = (const f32x4*)(SSQ + (size_t)(pm * BM + rloc + ai * HALF + m * 16) * 16); const f32x4 a = p[0], b = p[1], c = p[2], d = p[3];
                const float t = ((a[0] + a[1]) + (a[2] + a[3])) + ((b[0] + b[1]) + (b[2] + b[3])) + ((c[0] + c[1]) + (c[2] + c[3])) + ((d[0] + d[1]) + (d[2] + d[3]));
                rs[ai][m] = 1.0f / sqrtf(t * (1.0f / D) + RMS_EPS); }
    }
}
struct EpiProj {
    static constexpr bool PERM = true; static constexpr int NVMEM = 8;
    bf16* BB; bf16* UC; bf16* UB; bf16* GC; bf16* GS; const LAS unsigned char* lds; const float* SSQ;
    __device__ __forceinline__ void operator()(AccRef acc, const Unit& u, int wr, int wc, int fr, int fq) const {
        const int row0 = u.pm * BM + wr * 64 + fr, cl = wc * 32 + 8 * fq, pn = u.pn;
        float rs[2][4]; row_rstd(SSQ, lds, u.pm, wr * 64 + fr, rs); const LAS float* bias = (const LAS float*)(lds + T_BIAS);
        if (pn >= 4 && pn < 12) {
            const int q = pn - 4, ch = 128 * q + cl;
            const f32x4 bc0 = *(const LAS f32x4*)(bias + 1024 + ch), bc1 = *(const LAS f32x4*)(bias + 1024 + ch + 4), bv0 = *(const LAS f32x4*)(bias + 2048 + ch), bv1 = *(const LAS f32x4*)(bias + 2048 + ch + 4);
#pragma unroll
            for (int ai = 0; ai < 2; ++ai)
#pragma unroll
                for (int m = 0; m < 4; ++m) { const int row = row0 + ai * HALF + m * 16;
                    const float r = rs[ai][m]; const f32x4 p0 = (acc[ai][0][m][0] * r + bc0) * (acc[ai][1][m][0] * r + bv0), p1 = (acc[ai][0][m][1] * r + bc1) * (acc[ai][1][m][1] * r + bv1);
                    *(v4u*)(UC + (size_t)row * D + ch) = pack8(p0, p1); }
            return;
        }
#pragma unroll
        for (int bj = 0; bj < 2; ++bj) {
            const int dcol = pn * BM + bj * HALF + cl;
            const f32x4 b0 = *(const LAS f32x4*)(bias + dcol), b1 = *(const LAS f32x4*)(bias + dcol + 4);
#pragma unroll
            for (int ai = 0; ai < 2; ++ai)
#pragma unroll
                for (int m = 0; m < 4; ++m) { const int row = row0 + ai * HALF + m * 16;
                    f32x4 v0 = acc[ai][bj][m][0] * rs[ai][m] + b0, v1 = acc[ai][bj][m][1] * rs[ai][m] + b1;
                    if (pn < 4) { *(v4u*)(BB + (size_t)row * D + dcol) = pack8(v0, v1); }
                    else if (pn < 14) { const int cu = dcol - 3072, g = cu >> 4, cp = cu & 15;
                        *(v4u*)(UB + ((size_t)(row >> 5) * NG + g) * KY + (row & 31) * 16 + cp) = pack8(v0, v1); }
                    else {
#pragma unroll
                        for (int j = 0; j < 4; ++j) { v0[j] = sigmoid_f(v0[j]); v1[j] = sigmoid_f(v1[j]); }
                        if (pn < 18) *(v4u*)(GC + (size_t)row * D + (dcol - 3584)) = pack8(v0, v1);
                        else *(v4u*)(GS + (size_t)row * D + (dcol - 4608)) = pack8(v0, v1); } }
        }
    }
};
struct EpiSloc {
    static constexpr bool PERM = false; static constexpr int NVMEM = 16;
    float* SL;
    __device__ __forceinline__ void operator()(AccRef acc, const Unit& u, int wr, int wc, int fr, int fq) const {
        const int row0 = u.pm * BM + wr * 64 + fr, col0 = wc * 32 + 4 * fq;
#pragma unroll
        for (int ai = 0; ai < 2; ++ai)
#pragma unroll
            for (int m = 0; m < 4; ++m) { float* p = SL + ((size_t)(row0 + ai * HALF + m * 16) * NG + u.aux) * 128 + col0;
#pragma unroll
                for (int n = 0; n < 2; ++n) *(f32x4*)(p + n * 16) = acc[ai][0][m][n]; }
    }
};
struct EpiY {
    static constexpr bool PERM = true; static constexpr int NVMEM = 16;
    bf16* YB; const bf16* UB; const float* dsk;
    __device__ __forceinline__ void operator()(AccRef acc, const Unit& u, int wr, int wc, int fr, int fq) const {
        const int row0 = u.pm * BM + wr * 64 + fr, g = u.aux;
#pragma unroll
        for (int bj = 0; bj < 2; ++bj) {
            const int col = u.pn * BM + bj * HALF + wc * 32 + 8 * fq, j = col >> 4, c = col & 15, ch = g * 16 + c;
            const f32x4 d0 = *(const f32x4*)(dsk + ch), d1 = *(const f32x4*)(dsk + ch + 4);
#pragma unroll
            for (int ai = 0; ai < 2; ++ai)
#pragma unroll
                for (int m = 0; m < 4; ++m) { const int chunk = row0 + ai * HALF + m * 16;
                    const v4u uw = *(const v4u*)(UB + ((size_t)chunk * NG + g) * KY + j * 16 + c); f32x4 u0, u1; unpack8(uw, u0, u1);
                    f32x4 v0 = acc[ai][bj][m][0] + d0 * u0, v1 = acc[ai][bj][m][1] + d1 * u1;
#pragma unroll
                    for (int k = 0; k < 4; ++k) { v0[k] = gelu_tanh_f(v0[k]); v1[k] = gelu_tanh_f(v1[k]); }
                    *(v4u*)(YB + ((size_t)chunk * TCH + j) * DSSM + ch) = pack8(v0, v1); }
        }
    }
};
struct EpiConvOut {
    static constexpr bool PERM = true; static constexpr int NVMEM = 16;
    bf16* GC;
    __device__ __forceinline__ void operator()(AccRef acc, const Unit& u, int wr, int wc, int fr, int fq) const {
        const int row0 = u.pm * BM + wr * 64 + fr;
#pragma unroll
        for (int ai = 0; ai < 2; ++ai)
#pragma unroll
            for (int m = 0; m < 4; ++m)
#pragma unroll
                for (int bj = 0; bj < 2; ++bj) { bf16* p = GC + (size_t)(row0 + ai * HALF + m * 16) * D + u.pn * BM + bj * HALF + wc * 32 + 8 * fq;
                    f32x4 g0, g1; unpack8(*(const v4u*)p, g0, g1); *(v4u*)p = pack8(g0 * acc[ai][bj][m][0], g1 * acc[ai][bj][m][1]); }
    }
};
struct EpiGlu {
    static constexpr bool PERM = true; static constexpr int NVMEM = 8;
    bf16* P1; const bf16* GS;
    __device__ __forceinline__ void operator()(AccRef acc, const Unit& u, int wr, int wc, int fr, int fq) const {
        const int row0 = u.pm * BM + wr * 64 + fr, ch = u.pn * HALF + wc * 32 + 8 * fq;
#pragma unroll
        for (int ai = 0; ai < 2; ++ai)
#pragma unroll
            for (int m = 0; m < 4; ++m) { const size_t off = (size_t)(row0 + ai * HALF + m * 16) * D + ch;
                f32x4 p0, p1, s0, s1; unpack8(*(const v4u*)(P1 + off), p0, p1); unpack8(*(const v4u*)(GS + off), s0, s1);
                f32x4 z0 = acc[ai][0][m][0], z1 = acc[ai][0][m][1]; const f32x4 y0 = acc[ai][1][m][0], y1 = acc[ai][1][m][1];
#pragma unroll
                for (int k = 0; k < 4; ++k) { z0[k] = p0[k] + s0[k] * z0[k] * sigmoid_f(y0[k]); z1[k] = p1[k] + s1[k] * z1[k] * sigmoid_f(y1[k]); }
                *(v4u*)(P1 + off) = pack8(z0, z1); }
    }
};
struct EpiRes {
    static constexpr bool PERM = true; static constexpr int NVMEM = 16;
    bf16* XB; float* SSQ;
    __device__ __forceinline__ void operator()(AccRef acc, const Unit& u, int wr, int wc, int fr, int fq) const {
        const int row0 = u.pm * BM + wr * 64 + fr, col0 = u.pn * BM + wc * 32 + 8 * fq;
#pragma unroll
        for (int ai = 0; ai < 2; ++ai)
#pragma unroll
            for (int m = 0; m < 4; ++m) { const int row = row0 + ai * HALF + m * 16; float s = 0.f;
#pragma unroll
                for (int bj = 0; bj < 2; ++bj) { bf16* p = XB + (size_t)row * D + col0 + bj * HALF; f32x4 x0, x1; unpack8(*(const v4u*)p, x0, x1);
                    x0 += acc[ai][bj][m][0]; x1 += acc[ai][bj][m][1]; *(v4u*)p = pack8(x0, x1);
                    s += ((x0[0] * x0[0] + x0[1] * x0[1]) + (x0[2] * x0[2] + x0[3] * x0[3])) + ((x1[0] * x1[0] + x1[1] * x1[1]) + (x1[2] * x1[2] + x1[3] * x1[3])); }
                s += __shfl_xor(s, 16); s += __shfl_xor(s, 32);
                if (fq == 0) SSQ[(size_t)row * 16 + u.pn * 4 + wc] = s; }
    }
};
struct EpiSwiglu {
    static constexpr bool PERM = true; static constexpr int NVMEM = 8;
    bf16* H; const float* SSQ; const LAS unsigned char* lds;
    __device__ __forceinline__ void operator()(AccRef acc, const Unit& u, int wr, int wc, int fr, int fq) const {
        const int row0 = u.pm * BM + wr * 64 + fr, ch = u.pn * HALF + wc * 32 + 8 * fq;
        float rs[2][4]; row_rstd(SSQ, lds, u.pm, wr * 64 + fr, rs);
#pragma unroll
        for (int ai = 0; ai < 2; ++ai)
#pragma unroll
            for (int m = 0; m < 4; ++m) { const float r = rs[ai][m]; f32x4 g0 = acc[ai][0][m][0] * r, g1 = acc[ai][0][m][1] * r; const f32x4 u0 = acc[ai][1][m][0] * r, u1 = acc[ai][1][m][1] * r;
#pragma unroll
                for (int k = 0; k < 4; ++k) { g0[k] = g0[k] * sigmoid_f(g0[k]) * u0[k]; g1[k] = g1[k] * sigmoid_f(g1[k]) * u1[k]; }
                *(v4u*)(H + (size_t)(row0 + ai * HALF + m * 16) * DFF + ch) = pack8(g0, g1); }
    }
};
struct EpiSwiglu8 {
    static constexpr bool PERM = true; static constexpr int NVMEM = 8;
    unsigned char* H;
    __device__ __forceinline__ void operator()(AccRef acc, const Unit& u, int wr, int wc, int fr, int fq) const {
        const int row0 = u.pm * BM + wr * 64 + fr, ch = u.pn * HALF + wc * 32 + 8 * fq; const float sc = (float)(1 << HID_SH) / (float)(1 << (HN_SH + WGU_SH)), si = 1.0f / (float)(1 << (HN_SH + WGU_SH));
#pragma unroll
        for (int ai = 0; ai < 2; ++ai)
#pragma unroll
            for (int m = 0; m < 4; ++m) { f32x4 g0 = acc[ai][0][m][0], g1 = acc[ai][0][m][1]; const f32x4 u0 = acc[ai][1][m][0], u1 = acc[ai][1][m][1];
#pragma unroll
                for (int k = 0; k < 4; ++k) { const float a0 = g0[k] * si, a1 = g1[k] * si; g0[k] = clamp8(a0 * sigmoid_f(a0) * u0[k] * sc); g1[k] = clamp8(a1 * sigmoid_f(a1) * u1[k] * sc); }
                v2u w; w.x = pk4_fp8(g0[0], g0[1], g0[2], g0[3]); w.y = pk4_fp8(g1[0], g1[1], g1[2], g1[3]);
                *(v2u*)(H + (size_t)(row0 + ai * HALF + m * 16) * DFF + ch) = w; }
    }
};
struct EpiMoeDown {
    static constexpr bool PERM = true; static constexpr int NVMEM = 16;
    bf16* O; const float* roww;
    __device__ __forceinline__ void operator()(AccRef acc, const Unit& u, int wr, int wc, int fr, int fq) const {
        const int row0 = u.pm * BM + wr * 64 + fr;
#pragma unroll
        for (int ai = 0; ai < 2; ++ai)
#pragma unroll
            for (int m = 0; m < 4; ++m) { const int row = row0 + ai * HALF + m * 16; const float w = roww[row] * (1.0f / (float)(1 << (HID_SH + WD_SH)));
#pragma unroll
                for (int bj = 0; bj < 2; ++bj) *(v4u*)(O + (size_t)row * D + u.pn * BM + bj * HALF + wc * 32 + 8 * fq) = pack8(acc[ai][bj][m][0] * w, acc[ai][bj][m][1] * w); }
    }
};

template <bool FP8> __device__ __forceinline__ void tr_item2(const float* W, int N, int k0, int n0, unsigned char* dst, size_t ld_bytes, int drow0, float scale, LAS unsigned* scr, int lane, const float* gk = nullptr) {
    unsigned dw[32];
    const float* src = W + (size_t)k0 * N + n0 + lane;
    if constexpr (FP8) {
#pragma unroll
        for (int hlf = 0; hlf < 2; ++hlf) { float v[64];
#pragma unroll
            for (int i = 0; i < 64; ++i) v[i] = src[(size_t)(hlf * 64 + i) * N];
#pragma unroll
            for (int i = 0; i < 16; ++i) dw[hlf * 16 + i] = pk4_fp8(v[4 * i] * scale, v[4 * i + 1] * scale, v[4 * i + 2] * scale, v[4 * i + 3] * scale); }
    } else { float v[64];
#pragma unroll
        for (int i = 0; i < 64; ++i) v[i] = src[(size_t)i * N];
        if (gk) {
#pragma unroll
            for (int i = 0; i < 64; ++i) v[i] *= gk[k0 + i]; }
#pragma unroll
        for (int i = 0; i < 32; ++i) dw[i] = cvt_pk_bf16(v[2 * i], v[2 * i + 1]); }
#pragma unroll
    for (int i = 0; i < 8; ++i) *(LAS v4u*)(scr + lane * 36 + 4 * i) = (v4u){dw[4 * i], dw[4 * i + 1], dw[4 * i + 2], dw[4 * i + 3]};
    LDS_WAIT(); asm volatile("" ::: "memory");
    const int c = lane & 7; const size_t kb = (size_t)k0 * (FP8 ? 1 : 2);
#pragma unroll
    for (int j = 0; j < 8; ++j) { const int r = (lane >> 3) + 8 * j; const v4u o = *(const LAS v4u*)(scr + r * 36 + 4 * c);
        *(GAS v4u*)(dst + (size_t)(drow0 + r) * ld_bytes + kb + 16 * c) = o; }
    LDS_WAIT(); asm volatile("" ::: "memory");
}
__device__ __forceinline__ int pair_row(int ch, int second) { return (ch >> 7) * 256 + (ch & 127) + (second ? 128 : 0); }
__device__ __forceinline__ void p0_transposes(Frame& F) {
    LAS unsigned* scr = (LAS unsigned*)(F.lds + 49152 + F.wave * 9216);
    const int gw = F.vcu * 8 + F.wave, NGW = F.G * 8;
    constexpr int I_MGU = 8 * 56, I_MD = 28 * 16;
    constexpr int I_IN = 16 * 88, I_SQ = 16 * 16, I_GLU = 8 * 32, I_GU = 16 * 56, I_DN = 56 * 16;
    constexpr int N8 = 8 * (2 * I_MGU + I_MD), NIT = N8 + 2 * I_IN + 2 * I_SQ + 2 * I_GLU + 2 * I_SQ + 2 * I_GU + I_DN;
    unsigned char* ws = F.ws;
    for (int it = gw; it < NIT; it += NGW) {
        int r = it;
        if (r < N8) { const int e = r / (2 * I_MGU + I_MD); r %= (2 * I_MGU + I_MD);
            if (r < 2 * I_MGU) { const int sgu = r / I_MGU; r %= I_MGU; const int n0 = (r % 56) * 64;
                tr_item2<true>((sgu ? KIN(23) : KIN(22)) + (size_t)e * D * DFF, DFF, (r / 56) * 128, n0, ws + WS_WMGU + (size_t)e * 2 * DFF * D, D, pair_row(n0, sgu), (float)(1 << WGU_SH), scr, F.lane); }
            else { r -= 2 * I_MGU; tr_item2<true>(KIN(24) + (size_t)e * DFF * D, D, (r / 16) * 128, (r % 16) * 64, ws + WS_WMD + (size_t)e * D * DFF, DFF, (r % 16) * 64, (float)(1 << WD_SH), scr, F.lane); }
            continue; }
        r -= N8;
        if (r < 2 * I_IN) { const int l = r / I_IN; r %= I_IN; const int n0 = (r % 88) * 64; int d = n0;
            if (n0 >= 1024 && n0 < 2048) d = 1024 + pair_row(n0 - 1024, 0); else if (n0 >= 2048 && n0 < 3072) d = 1024 + pair_row(n0 - 2048, 1);
            tr_item2<false>(KIN(2) + (size_t)l * D * PW, PW, (r / 88) * 64, n0, ws + WS_WIN + (size_t)l * PW * D * 2, D * 2, d, 1.f, scr, F.lane, KIN(1) + l * D); continue; }
        r -= 2 * I_IN;
        if (r < 2 * I_SQ) { const int l = r / I_SQ; r %= I_SQ; tr_item2<false>(KIN(5) + (size_t)l * D * D, D, (r / 16) * 64, (r % 16) * 64, ws + WS_WCO + (size_t)l * D * D * 2, D * 2, (r % 16) * 64, 1.f, scr, F.lane); continue; }
        r -= 2 * I_SQ;
        if (r < 2 * I_GLU) { const int l = r / I_GLU; r %= I_GLU; const int n0 = (r % 32) * 64; const int d = n0 < 1024 ? pair_row(n0, 0) : pair_row(n0 - 1024, 1);
            tr_item2<false>(KIN(14) + (size_t)l * DSSM * 2048, 2048, (r / 32) * 64, n0, ws + WS_WGLU + (size_t)l * 2048 * DSSM * 2, DSSM * 2, d, 1.f, scr, F.lane); continue; }
        r -= 2 * I_GLU;
        if (r < 2 * I_SQ) { const int l = r / I_SQ; r %= I_SQ; tr_item2<false>(KIN(15) + (size_t)l * D * D, D, (r / 16) * 64, (r % 16) * 64, ws + WS_WO + (size_t)l * D * D * 2, D * 2, (r % 16) * 64, 1.f, scr, F.lane); continue; }
        r -= 2 * I_SQ;
        if (r < 2 * I_GU) { const int sgu = r / I_GU; r %= I_GU; const int n0 = (r % 56) * 64;
            tr_item2<false>(sgu ? KIN(18) : KIN(17), DFF, (r / 56) * 64, n0, ws + WS_WDGU, D * 2, pair_row(n0, sgu), 1.f, scr, F.lane, KIN(16)); continue; }
        r -= 2 * I_GU;
        tr_item2<false>(KIN(19), D, (r / 16) * 64, (r % 16) * 64, ws + WS_WDD, DFF * 2, (r % 16) * 64, 1.f, scr, F.lane);
    }
}
__device__ __forceinline__ void p0_ssm_job(Frame& F, int l, int g, int cq) {
    LAS f32x2* pw = (LAS f32x2*)(F.lds);
    LAS f32x2* bbL = pw + 33 * 64;
    LAS f32x2* CL = bbL + 64 * 16;
    LAS float* KmL = (LAS float*)(CL + 16 * 64);
    const int t = F.tid, lg = l * NG + g;
    const float* a_re = KIN(6); const float* a_im = KIN(7); const float* ldt = KIN(8); const float* b_re = KIN(9); const float* b_im = KIN(10); const float* c_re = KIN(11); const float* c_im = KIN(12);
    for (int idx = t; idx < 1024; idx += 512) CL[idx] = (f32x2){c_re[(size_t)lg * 1024 + idx], c_im[(size_t)lg * 1024 + idx]};
    if (t < 64) {
        const int n = t; const float ar = a_re[lg * 64 + n], ai = a_im[lg * 64 + n], dt = expf(ldt[lg]);
        const float mag = expf(ar * dt), ang = ai * dt; float sn, cs; sn = sinf(ang); cs = cosf(ang);
        const float are = mag * cs, aim = mag * sn, den = ar * ar + ai * ai, nr = are - 1.0f, ni = aim;
        const float cre = (nr * ar + ni * ai) / den, cim = (ni * ar - nr * ai) / den;
        float pr = 1.0f, pi = 0.0f; pw[n] = (f32x2){1.0f, 0.0f};
        for (int d = 1; d <= TCH; ++d) { const float qr = pr * are - pi * aim, qi = pr * aim + pi * are; pr = qr; pi = qi; pw[d * 64 + n] = (f32x2){pr, pi}; }
        if (cq == 0) ((f32x2*)(F.ws + WS_AT))[lg * 64 + n] = (f32x2){pr, pi};
#pragma unroll
        for (int c = 0; c < 16; ++c) { const float br = b_re[((size_t)lg * 64 + n) * 16 + c], bi = b_im[((size_t)lg * 64 + n) * 16 + c]; bbL[n * 16 + c] = (f32x2){cre * br - cim * bi, cre * bi + cim * br}; }
    }
    __syncthreads();
    { const int cp = t & 15, cc = (t >> 4) & 3, dq = t >> 6;
#pragma unroll
      for (int r = 0; r < 4; ++r) { const int d = dq * 4 + r; float s = 0.f;
          for (int n = 0; n < 64; ++n) { const f32x2 C = CL[(4 * cq + cc) * 64 + n], p = pw[d * 64 + n], b = bbL[n * 16 + cp];
              const float xr = C.x * p.x - C.y * p.y, xi = C.x * p.y + C.y * p.x; s += xr * b.x - xi * b.y; }
          KmL[(d * 4 + cc) * 16 + cp] = s; } }
    __syncthreads();
    const int q = F.lane, i = q >> 1, c0 = (q & 1) * 8;
    for (int rr = F.wave; rr < 128; rr += 8) {
        const int j = rr >> 2, cc = rr & 3, c = 4 * cq + cc;
        bf16* dst = (bf16*)(F.ws + WS_BTY) + ((size_t)lg * 512 + j * 16 + c) * KY;
        float v[8];
#pragma unroll
        for (int e = 0; e < 8; ++e) v[e] = (i <= j) ? KmL[((j - i) * 4 + cc) * 16 + c0 + e] : 0.0f;
        v4u o; o.x = cvt_pk_bf16(v[0], v[1]); o.y = cvt_pk_bf16(v[2], v[3]); o.z = cvt_pk_bf16(v[4], v[5]); o.w = cvt_pk_bf16(v[6], v[7]);
        *(GAS v4u*)(dst + q * 8) = o;
        if (q < 16) { const int part = q >> 3, n0 = (q & 7) * 8;
#pragma unroll
            for (int e = 0; e < 8; ++e) { const f32x2 C = CL[c * 64 + n0 + e], p = pw[(j + 1) * 64 + n0 + e]; v[e] = part ? -(C.x * p.y + C.y * p.x) : (C.x * p.x - C.y * p.y); }
            o.x = cvt_pk_bf16(v[0], v[1]); o.y = cvt_pk_bf16(v[2], v[3]); o.z = cvt_pk_bf16(v[4], v[5]); o.w = cvt_pk_bf16(v[6], v[7]);
            *(GAS v4u*)(dst + 512 + q * 8) = o; }
    }
    for (int rr = F.wave * 4; rr < F.wave * 4 + 4; ++rr) {
        const int part = rr >> 4, n = 16 * cq + (rr & 15);
        bf16* dst = (bf16*)(F.ws + WS_BTS) + ((size_t)lg * 128 + part * 64 + n) * 512;
        const f32x2 p = pw[(TCH - 1 - i) * 64 + n]; float v[8];
#pragma unroll
        for (int e = 0; e < 8; ++e) { const f32x2 b = bbL[n * 16 + c0 + e]; v[e] = part ? (p.x * b.y + p.y * b.x) : (p.x * b.x - p.y * b.y); }
        v4u o; o.x = cvt_pk_bf16(v[0], v[1]); o.y = cvt_pk_bf16(v[2], v[3]); o.z = cvt_pk_bf16(v[4], v[5]); o.w = cvt_pk_bf16(v[6], v[7]);
        *(GAS v4u*)(dst + q * 8) = o;
    }
    __syncthreads();
}

__device__ __forceinline__ void t_xcvt(Frame& F, const float* X, bf16* XB, float* SSQ) {
    const int gw = F.vcu * 8 + F.wave, NGW = F.G * 8;
    for (int m = gw; m < M; m += NGW) {
        const f32x4* xr = (const f32x4*)(X + (size_t)m * D) + F.lane; f32x4 v[4]; float s = 0.f;
#pragma unroll
        for (int j = 0; j < 4; ++j) { v[j] = xr[64 * j]; s += (v[j][0] * v[j][0] + v[j][1] * v[j][1]) + (v[j][2] * v[j][2] + v[j][3] * v[j][3]); }
        s = wave_sum(s);
        v2u* o = (v2u*)(XB + (size_t)m * D) + F.lane;
#pragma unroll
        for (int j = 0; j < 4; ++j) { v2u w; w.x = cvt_pk_bf16(v[j][0], v[j][1]); w.y = cvt_pk_bf16(v[j][2], v[j][3]); o[64 * j] = w; }
        if (F.lane < 16) SSQ[(size_t)m * 16 + F.lane] = F.lane == 0 ? s : 0.f;
    }
}
__device__ __forceinline__ void t_norm_router(Frame& F, const bf16* X, const float* gvec, bf16* HN, const float* rw, const float* rb) {
    f32x4 g[4]; f32x4 rwv[4][4][2];
#pragma unroll
    for (int j = 0; j < 4; ++j) { g[j] = ((const f32x4*)gvec)[F.lane + 64 * j];
#pragma unroll
        for (int c = 0; c < 4; ++c) { const f32x4* p = (const f32x4*)(rw + (size_t)(4 * (F.lane + 64 * j) + c) * NE); rwv[j][c][0] = p[0]; rwv[j][c][1] = p[1]; } }
    LAS int* selE = (LAS int*)(F.lds + T_SELE); LAS float* selW = (LAS float*)(F.lds + T_SELW);
    for (int k = 0; k < 8; ++k) {
        const int tl = F.wave * 8 + k, m = F.bid * 64 + tl;
        const v2u* xr = (const v2u*)(X + (size_t)m * D) + F.lane; f32x4 v[4]; float s = 0.f;
#pragma unroll
        for (int j = 0; j < 4; ++j) { const v2u a = xr[64 * j]; v[j] = (f32x4){bf_lo(a.x), bf_hi(a.x), bf_lo(a.y), bf_hi(a.y)}; s += (v[j][0] * v[j][0] + v[j][1] * v[j][1]) + (v[j][2] * v[j][2] + v[j][3] * v[j][3]); }
        const float rstd = 1.0f / sqrtf(wave_sum(s) * (1.0f / D) + RMS_EPS);
        unsigned* o = (unsigned*)((unsigned char*)HN + (size_t)m * D) + F.lane; const float hsc = (float)(1 << HN_SH);
        float lg[8];
#pragma unroll
        for (int e = 0; e < 8; ++e) lg[e] = 0.f;
#pragma unroll
        for (int j = 0; j < 4; ++j) { const f32x4 y = v[j] * rstd * g[j]; o[64 * j] = pk4_fp8(clamp8(y[0] * hsc), clamp8(y[1] * hsc), clamp8(y[2] * hsc), clamp8(y[3] * hsc));
#pragma unroll
            for (int c = 0; c < 4; ++c)
#pragma unroll
                for (int e = 0; e < 8; ++e) lg[e] += y[c] * rwv[j][c][e >> 2][e & 3]; }
#pragma unroll
        for (int e = 0; e < 8; ++e) lg[e] = wave_sum(lg[e]) + rb[e];
        int e0 = 0; float v0 = lg[0];
#pragma unroll
        for (int e = 1; e < 8; ++e) if (lg[e] > v0) { v0 = lg[e]; e0 = e; }
        int e1 = -1; float v1 = -3.0e38f;
#pragma unroll
        for (int e = 0; e < 8; ++e) if (e != e0 && lg[e] > v1) { v1 = lg[e]; e1 = e; }
        const float w0 = 1.0f / (1.0f + expf(v1 - v0)), w1 = 1.0f - w0;
        if (F.lane == 0) { selE[tl] = e0 | (e1 << 4); selW[tl * 2] = w0; selW[tl * 2 + 1] = w1;
            ((int*)(F.ws + WS_SELE))[m] = e0 | (e1 << 4); ((float*)(F.ws + WS_SELW))[2 * m] = w0; ((float*)(F.ws + WS_SELW))[2 * m + 1] = w1; }
    }
    __syncthreads();
    if (F.tid < 8) { int c = 0; for (int i = 0; i < 64; ++i) { const int se = selE[i]; c += ((se & 15) == F.tid || (se >> 4) == F.tid) ? 1 : 0; } ((int*)(F.ws + WS_CNTG))[F.bid * 8 + F.tid] = c; }
}
__device__ __forceinline__ void build_panels(Frame& F) {
    LAS int* cn = (LAS int*)F.lds;
    LAS int* pexp = (LAS int*)(F.lds + T_PEXP); LAS int* tt = (LAS int*)(F.lds + T_TOT);
    const int* cg = (const int*)(F.ws + WS_CNTG);
    for (int i = F.tid; i < F.G * 8; i += 512) cn[i] = cg[i];
    __syncthreads();
    if (F.tid < 8) { int tot = 0, off = 0; for (int b = 0; b < F.G; ++b) { const int c = cn[b * 8 + F.tid]; tot += c; off += (b < F.bid) ? c : 0; } tt[F.tid] = tot; tt[8 + F.tid] = off; }
    __syncthreads();
    if (F.tid == 0) { int p = 0; for (int e = 0; e < 8; ++e) { const int np = (tt[e] + 255) >> 8; tt[16 + e] = p * 256; tt[24 + e] = np; for (int k = 0; k < np; ++k) pexp[p + k] = e; p += np; } pexp[MOE_PANELS] = p; }
    __syncthreads();
}
__device__ __forceinline__ void t_perm(Frame& F) {
    build_panels(F);
    LAS int* selE = (LAS int*)(F.lds + T_SELE); LAS float* selW = (LAS float*)(F.lds + T_SELW); LAS int* tt = (LAS int*)(F.lds + T_TOT);
    if (F.tid < 64) selE[F.tid] = ((const int*)(F.ws + WS_SELE))[F.bid * 64 + F.tid];
    if (F.tid < 128) selW[F.tid] = ((const float*)(F.ws + WS_SELW))[F.bid * 128 + F.tid];
    __syncthreads();
    int* rowtok = (int*)(F.ws + WS_ROWTOK); float* roww = (float*)(F.ws + WS_ROWW); int* tokpos = (int*)(F.ws + WS_TOKPOS);
    if (F.tid < 8) { const int e = F.tid; int pos = tt[16 + e] + tt[8 + e];
        for (int i = 0; i < 64; ++i) { const int se = selE[i]; const int slot = ((se & 15) == e) ? 0 : (((se >> 4) == e) ? 1 : -1);
            if (slot >= 0) { const int m = F.bid * 64 + i; rowtok[pos] = m; roww[pos] = selW[i * 2 + slot]; tokpos[m * 2 + slot] = pos; ++pos; } } }
    if (F.bid < 8 && F.tid >= 64 && F.tid < 320) { const int e = F.bid, r = tt[e] + (F.tid - 64); if (r < tt[24 + e] * 256) { rowtok[tt[16 + e] + r] = 0; roww[tt[16 + e] + r] = 0.f; } }
}
__device__ __forceinline__ void t_conv(Frame& F, bf16* BB, const bf16* UC, const float* cw, int rank, int nranks) {
    if (rank < 0) return;
    const int gt = rank * 512 + F.tid, NT = nranks * 512, c8 = (gt & 127) * 8;
    f32x4 w[3][2];
#pragma unroll
    for (int k = 0; k < 3; ++k) { w[k][0] = *(const f32x4*)(cw + k * D + c8); w[k][1] = *(const f32x4*)(cw + k * D + c8 + 4); }
    for (int idx = gt; idx < M * 128; idx += NT) {
        const int m = idx >> 7, tpos = m & (SEQ - 1); const size_t off = (size_t)m * D + c8;
        f32x4 a0, a1, x0, x1; unpack8(*(const v4u*)(UC + off), x0, x1); a0 = w[2][0] * x0; a1 = w[2][1] * x1;
        if (tpos >= 1) { unpack8(*(const v4u*)(UC + off - D), x0, x1); a0 += w[1][0] * x0; a1 += w[1][1] * x1; }
        if (tpos >= 2) { unpack8(*(const v4u*)(UC + off - 2 * D), x0, x1); a0 += w[0][0] * x0; a1 += w[0][1] * x1; }
        unpack8(*(const v4u*)(BB + off), x0, x1);
        *(v4u*)(BB + off) = pack8(a0 * x0, a1 * x1);
    }
}
__device__ __forceinline__ void t_carry4(Frame& F, int l, int pm, int g, const float* SL, bf16* UB) {
    LAS float* sl = (LAS float*)F.lds;
#pragma unroll
    for (int j = 0; j < 16; ++j) { const int i4 = F.tid + 512 * j, ck = i4 >> 5, q = i4 & 31;
        *(LAS f32x4*)(sl + i4 * 4) = *(const f32x4*)(SL + ((size_t)(pm * 256 + ck) * NG + g) * 128 + 4 * q); }
    __syncthreads();
    if (F.wave < 4) { const int n = F.lane, bb = F.wave; const f32x2 a = ((const f32x2*)(F.ws + WS_AT))[(l * NG + g) * 64 + n]; float sr = 0.f, si = 0.f;
        for (int k = 0; k < 64; ++k) { const int ck = bb * 64 + k; bf16* dst = UB + ((size_t)(pm * 256 + ck) * NG + g) * KY + 512;
            const unsigned pr = cvt_pk_bf16(sr, si); dst[n] = (bf16)(pr & 0xffffu); dst[64 + n] = (bf16)(pr >> 16);
            const float lr = sl[ck * 128 + n], li = sl[ck * 128 + 64 + n]; const float nr = a.x * sr - a.y * si + lr, ni = a.x * si + a.y * sr + li; sr = nr; si = ni; } }
    __syncthreads();
}
__device__ __forceinline__ void t_combine_final(Frame& F, const bf16* XB, float* OUT, const bf16* O, const float* gvec) {
    const int gw = F.vcu * 8 + F.wave, NGW = F.G * 8; const int* tokpos = (const int*)(F.ws + WS_TOKPOS);
    f32x4 g[4];
#pragma unroll
    for (int j = 0; j < 4; ++j) g[j] = ((const f32x4*)gvec)[F.lane + 64 * j];
    for (int m = gw; m < M; m += NGW) {
        const int p0 = tokpos[2 * m], p1 = tokpos[2 * m + 1];
        f32x4* xr = (f32x4*)(OUT + (size_t)m * D) + F.lane; const v2u* xb = (const v2u*)(XB + (size_t)m * D) + F.lane; const v2u* o0 = (const v2u*)(O + (size_t)p0 * D) + F.lane; const v2u* o1 = (const v2u*)(O + (size_t)p1 * D) + F.lane;
        f32x4 v[4]; float s = 0.f;
#pragma unroll
        for (int j = 0; j < 4; ++j) { const v2u a = o0[64 * j], b = o1[64 * j];
            const v2u c = xb[64 * j];
            v[j] = (f32x4){bf_lo(c.x), bf_hi(c.x), bf_lo(c.y), bf_hi(c.y)} + (f32x4){bf_lo(a.x), bf_hi(a.x), bf_lo(a.y), bf_hi(a.y)} + (f32x4){bf_lo(b.x), bf_hi(b.x), bf_lo(b.y), bf_hi(b.y)};
            s += (v[j][0] * v[j][0] + v[j][1] * v[j][1]) + (v[j][2] * v[j][2] + v[j][3] * v[j][3]); }
        const float rstd = 1.0f / sqrtf(wave_sum(s) * (1.0f / D) + RMS_EPS);
#pragma unroll
        for (int j = 0; j < 4; ++j) xr[64 * j] = v[j] * rstd * g[j];
    }
}

#ifndef PHMASK
#define PHMASK 0xFFFFFFFFu
#endif
#define EN(k) ((PHMASK >> (k)) & 1u)
#ifndef DUPMASK
#define DUPMASK 0u
#endif
#define REP(k) for (int rep_ = 0; rep_ < 1 + (int)((DUPMASK >> (k)) & 1u); ++rep_)
#define IN(p) (lo <= (p) && (p) < hi)
#define SEAM(p) do { if (multi && (p) + 1 < hi) xcd_barrier(bar); } while (0)
#define RING ((LAS unsigned char*)lds_raw)
template <int L> __device__ __forceinline__ void layer_phases(const int lo0, const int hi0, const bool multi, const XcdBarrier& bar, unsigned char* lds_raw) {
    constexpr int l = L;
    int lo = lo0, hi = hi0, G = gridDim.x, cidx = blockIdx.x; asm volatile("" : "+s"(lo), "+s"(hi), "+s"(G), "+s"(cidx));
    {
        const int pb = 1 + 16 * l;
        if (IN(pb + 1) && EN(2)) REP(2) {
            unsigned char* ws = KWS;
            SchedPlain S; S.o.init(M / 256, PW / 256, G, cidx); S.A = (const char*)(ws + WS_XB); S.B = (const char*)(ws + WS_WIN) + (size_t)l * PW * D * 2; S.tA = (size_t)256 * D * 2; S.tB = (size_t)256 * D * 2;
            EpiProj E{(bf16*)(ws + WS_BB), (bf16*)(ws + WS_UC), (bf16*)(ws + WS_UB), (bf16*)(ws + WS_GC), (bf16*)(ws + WS_GS), RING, (const float*)(ws + WS_SSQ)};
            { MKFRAME(F); prep_rstd(F, S.o, (const float*)(ws + WS_SSQ)); prep_bias(F, KIN(3) + (size_t)l * PW); }
            pg8::gemm_phase<EpiProj, SchedPlain, false, true>(RING, D * 2, D * 2, D * 2, S, E);
            { int pm_, pn_; if (!S.o.tile(5, pm_, pn_)) { MKFRAME(F); __syncthreads(); for (int job = cidx - 128; job >= 0 && job < NG * 4; job += 128) p0_ssm_job(F, l, job >> 2, job & 3); } }
            SEAM(pb + 1);
        }
        if (IN(pb + 2) && EN(3)) REP(3) {
            unsigned char* ws = KWS;
            { SchedSsmS S; S.o.init(2, NG, G, cidx); S.UB = (const char*)(ws + WS_UB); S.BTS = (const char*)(ws + WS_BTS) + (size_t)l * NG * 128 * 512 * 2;
              EpiSloc E{(float*)(ws + WS_HN + 16 * MiB)};
              pg8::gemm_phase<EpiSloc, SchedSsmS, false, true>(RING, 512 * 2, NG * KY * 2, 512 * 2, S, E);
              { int pm_, g_; if (S.o.tile(0, pm_, g_)) { MKFRAME(F); t_carry4(F, l, pm_, g_, (const float*)(F.ws + WS_HN + 16 * MiB), (bf16*)(F.ws + WS_UB)); } } }
            { MKFRAME(F); t_conv(F, (bf16*)(F.ws + WS_BB), (const bf16*)(F.ws + WS_UC), KIN(4) + (size_t)l * 3 * D, G == 256 ? cidx - 64 : cidx, G == 256 ? 192 : G); }
            SEAM(pb + 2);
        }
        if (IN(pb + 4) && EN(5)) REP(5) {
            { unsigned char* ws = KWS;
              SchedSsmY S; S.o.init(2, 2 * NG, G, cidx); S.UB = (const char*)(ws + WS_UB); S.BTY = (const char*)(ws + WS_BTY) + (size_t)l * NG * 512 * KY * 2;
              EpiY E{(bf16*)(ws + WS_HN), (const bf16*)(ws + WS_UB), KIN(13) + (size_t)l * DSSM};
              pg8::gemm_phase<EpiY, SchedSsmY, false, true>(RING, KY * 2, NG * KY * 2, KY * 2, S, E); }
            { unsigned char* ws = KWS;
              SchedPlain S; S.o.init(M / 256, D / 256, G, cidx); S.A = (const char*)(ws + WS_BB); S.B = (const char*)(ws + WS_WCO) + (size_t)l * D * D * 2; S.tA = (size_t)256 * D * 2; S.tB = (size_t)256 * D * 2;
              EpiConvOut E{(bf16*)(ws + WS_GC)};
              pg8::gemm_phase<EpiConvOut, SchedPlain, false, true>(RING, D * 2, D * 2, D * 2, S, E); }
            SEAM(pb + 4);
        }
        if (IN(pb + 5) && EN(6)) REP(6) {
            unsigned char* ws = KWS;
            SchedPlain S; S.o.init(M / 256, 2048 / 256, G, cidx); S.A = (const char*)(ws + WS_HN); S.B = (const char*)(ws + WS_WGLU) + (size_t)l * 2048 * DSSM * 2; S.tA = (size_t)256 * DSSM * 2; S.tB = (size_t)256 * DSSM * 2;
            EpiGlu E{(bf16*)(ws + WS_GC), (const bf16*)(ws + WS_GS)};
            pg8::gemm_phase<EpiGlu, SchedPlain, false, true>(RING, DSSM * 2, DSSM * 2, DSSM * 2, S, E);
            SEAM(pb + 5);
        }
        if (IN(pb + 6) && EN(7)) REP(7) {
            unsigned char* ws = KWS;
            SchedPlain S; S.o.init(M / 256, D / 256, G, cidx); S.A = (const char*)(ws + WS_GC); S.B = (const char*)(ws + WS_WO) + (size_t)l * D * D * 2; S.tA = (size_t)256 * D * 2; S.tB = (size_t)256 * D * 2;
            EpiRes E{(bf16*)(ws + WS_XB), (float*)(ws + WS_SSQ)};
            pg8::gemm_phase<EpiRes, SchedPlain, false, true>(RING, D * 2, D * 2, D * 2, S, E);
            SEAM(pb + 6);
        }
        if (IN(pb + 7) && EN(8) && L == 1) REP(8) {
            MKFRAME(F);
            t_norm_router(F, (const bf16*)(F.ws + WS_XB), KIN(16) + D, (bf16*)(F.ws + WS_HN), KIN(20), KIN(21));
            SEAM(pb + 7);
        }
        if constexpr (L == 0) {
            if (IN(pb + 9) && EN(10)) REP(10) {
                unsigned char* ws = KWS;
                SchedPlain S; S.o.init(M / 256, 2 * DFF / 256, G, cidx); S.A = (const char*)(ws + WS_XB); S.B = (const char*)(ws + WS_WDGU); S.tA = (size_t)256 * D * 2; S.tB = (size_t)256 * D * 2;
                EpiSwiglu E{(bf16*)(ws + WS_HID), (const float*)(ws + WS_SSQ), RING};
                { MKFRAME(F); prep_rstd(F, S.o, (const float*)(ws + WS_SSQ)); }
                pg8::gemm_phase<EpiSwiglu, SchedPlain, false, true>(RING, D * 2, D * 2, D * 2, S, E);
                SEAM(pb + 9);
            }
            if (IN(pb + 10) && EN(11)) REP(11) {
                unsigned char* ws = KWS;
                SchedPlain S; S.o.init(M / 256, D / 256, G, cidx); S.A = (const char*)(ws + WS_HID); S.B = (const char*)(ws + WS_WDD); S.tA = (size_t)256 * DFF * 2; S.tB = (size_t)256 * DFF * 2;
                EpiRes E{(bf16*)(ws + WS_XB), (float*)(ws + WS_SSQ)};
                pg8::gemm_phase<EpiRes, SchedPlain, false, true>(RING, DFF * 2, DFF * 2, DFF * 2, S, E);
                SEAM(pb + 10);
            }
        } else {
            if (IN(pb + 8) && EN(9)) { MKFRAME(F); t_perm(F); SEAM(pb + 8); }
            const LAS int* pexp = (const LAS int*)(RING + T_PEXP);
            if (IN(pb + 9) && EN(12)) REP(12) {
                if (lo > pb + 8) { MKFRAME(F); build_panels(F); }
                unsigned char* ws = KWS;
                SchedMoe1 S; S.o.init(pexp[MOE_PANELS], 2 * DFF / 256, G, cidx); S.HN = (const char*)(ws + WS_HN); S.W = (const char*)(ws + WS_WMGU); S.rowtok = (const int*)(ws + WS_ROWTOK); S.pexp = pexp;
                EpiSwiglu8 E{(unsigned char*)(ws + WS_HID)};
                pg8::gemm_phase<EpiSwiglu8, SchedMoe1, true, true, true>(RING, D, D, D, S, E);
                SEAM(pb + 9);
            }
            if (IN(pb + 10) && EN(13)) REP(13) {
                if (lo > pb + 8) { MKFRAME(F); build_panels(F); }
                unsigned char* ws = KWS;
                SchedMoe2 S; S.o.init(pexp[MOE_PANELS], D / 256, G, cidx); S.HID = (const char*)(ws + WS_HID); S.W = (const char*)(ws + WS_WMD); S.pexp = pexp;
                EpiMoeDown E{(bf16*)(ws + WS_MOEO), (const float*)(ws + WS_ROWW)};
                pg8::gemm_phase<EpiMoeDown, SchedMoe2, false, true, true>(RING, DFF, DFF, DFF, S, E);
                SEAM(pb + 10);
            }
            if (IN(pb + 11) && EN(14)) { MKFRAME(F); t_combine_final(F, (const bf16*)(F.ws + WS_XB), KOUT, (const bf16*)(F.ws + WS_MOEO), KIN(25)); }
        }
    }
}
struct Args { const float* in[26]; float* out; unsigned char* ws; int ph_lo, ph_hi; };
constexpr int N_PHASES = 1 + 32;
__global__ void __launch_bounds__(512, 2) fwd_kernel(Args args) {
    extern __shared__ __attribute__((aligned(16))) unsigned char lds_raw[];
    const int lo0 = args.ph_lo, hi0 = args.ph_hi; const bool multi = (hi0 - lo0) > 1;
    volatile LAS unsigned* MISC = (volatile LAS unsigned*)((LAS unsigned char*)lds_raw + T_MISC);
    if (threadIdx.x < 32) MISC[threadIdx.x] = 0u;
    __syncthreads();
    XcdBarrier bar; bar.bar = (unsigned*)(KWS + WS_CTL) + CW_BAR; bar.x = 0; bar.st = MISC + 8;
    if (multi) bar = xcd_barrier_post((unsigned*)(KWS + WS_CTL) + CW_BAR, MISC + 8);
    int lo = lo0, hi = hi0, G = gridDim.x, cidx = blockIdx.x;

    if (IN(0) && EN(0)) REP(0) {
        MKFRAME(F); unsigned char* ws = F.ws;
        p0_transposes(F);
        t_xcvt(F, KIN(0), (bf16*)(ws + WS_XB), (float*)(ws + WS_SSQ));
        SEAM(0);
    }
    layer_phases<0>(lo0, hi0, multi, bar, lds_raw);
    layer_phases<1>(lo0, hi0, multi, bar, lds_raw);
#undef IN
#undef REP
#undef EN
#undef SEAM
#undef RING
}

extern "C" void kernel_launch(void* const* d_in, const int* in_sizes, int n_in, void* d_out, int out_size, void* d_ws, size_t ws_size, hipStream_t stream) {
    static int grid = 0;
    if (grid == 0) {
        if (n_in != 26 || in_sizes[0] != M * D || out_size != M * D || ws_size < WS_END) { fprintf(stderr, "kernel_launch: unexpected shapes / workspace (%zu < %zu)\n", ws_size, (size_t)WS_END); grid = -1; return; }
        int dev = 0, cus = 0;
        if (hipGetDevice(&dev) != hipSuccess || hipDeviceGetAttribute(&cus, hipDeviceAttributeMultiprocessorCount, dev) != hipSuccess) { grid = -1; return; }
        if (hipFuncSetAttribute((const void*)fwd_kernel, hipFuncAttributeMaxDynamicSharedMemorySize, LDS_BYTES) != hipSuccess) { grid = -1; return; }
        (void)hipGetLastError();
        grid = 256;
        if (cus < 256) { fprintf(stderr, "kernel_launch: needs 256 CUs, device has %d\n", cus); grid = -1; return; }
    }
    if (grid < 0) return;
    Args a{};
    for (int i = 0; i < 26; ++i) a.in[i] = (const float*)d_in[i];
    a.out = (float*)d_out; a.ws = (unsigned char*)d_ws;
#if MK_PER_PHASE
    static const int phases[] = {0, 2, 3, 5, 6, 7, 10, 11, 18, 19, 21, 22, 23, 24, 25, 26, 27, 28};
    for (int p : phases) {
        if (p == 1) continue;
        a.ph_lo = p; a.ph_hi = p + 1;
        hipLaunchKernelGGL(fwd_kernel, dim3(grid), dim3(512), LDS_BYTES, stream, a);
    }
#else
    (void)hipMemsetAsync((char*)d_ws + WS_CTL, 0, CTL_ZERO_BYTES, stream);
    a.ph_lo = 0; a.ph_hi = N_PHASES;
    hipLaunchKernelGGL(fwd_kernel, dim3(grid), dim3(512), LDS_BYTES, stream, a);
#endif
}
```

```cpp
#include <hip/hip_runtime.h>
#include <cstdio>
#include <cstdint>

#ifndef MK_PER_PHASE
#define MK_PER_PHASE 0
#endif

constexpr int M = 16384, D = 1024, SEQ = 2048, PW = 5632, DFF = 3584, NE = 8, DSSM = 512;
constexpr int TCH = 32, NCH = M / TCH, NG = 32, KY = 640;
constexpr int MOE_ROWS = 34816, MOE_PANELS = 136;
constexpr float RMS_EPS = 1e-6f;

namespace pg8 {
#define PG8_LAS __attribute__((address_space(3)))
typedef unsigned short bf16_t;
typedef short bf16x8 __attribute__((ext_vector_type(8)));
typedef float f32x4 __attribute__((ext_vector_type(4)));
typedef float f32x2 __attribute__((ext_vector_type(2)));
typedef unsigned u32x4 __attribute__((ext_vector_type(4)));
typedef unsigned u32x2 __attribute__((ext_vector_type(2)));
constexpr int BM = 256, BK = 64, HALF = 128, HTB = HALF * BK * 2, STAGE_BYTES = 8 * HTB, NXCD = 8, WGM = 8;

__host__ __device__ __forceinline__ int lds_byte(int r, int c) { const int st = (r >> 4) * 2 + (c >> 5), rr = r & 15, cc = c & 31, ob = rr * 64 + cc * 2; return st * 1024 + (ob ^ (((ob >> 9) & 1) << 5)); }
__host__ __device__ __forceinline__ void stage_rc(int b, int& R, int& C) { const int st = b / 1024, sb = b % 1024, swz = sb ^ (((sb >> 9) & 1) << 5); R = (st >> 1) * 16 + swz / 64; C = (st & 1) * 32 + (swz % 64) / 2; }
__host__ __device__ __forceinline__ int perm32(int rho) { const int n = rho >> 4, i = rho & 15; return 8 * (i >> 2) + 4 * n + (i & 3); }

struct Unit { int pm, pn, aux; const char* A; const char* B; const int* tok; };

struct Order {
    int nM, nN, nwg, G, c;
    __device__ __forceinline__ void init(int nM_, int nN_, int G_, int c_) { nM = nM_; nN = nN_; nwg = nM * nN; G = G_; c = c_; }
    __device__ __forceinline__ bool tile(int i, int& pm, int& pn) const {
        const long L = (long)i * G + c; if (L >= nwg) return false;
        int wgid = (int)L; { const int q = nwg / NXCD, r = nwg % NXCD, xcd = wgid % NXCD, off = wgid / NXCD; wgid = (xcd < r ? xcd * (q + 1) : r * (q + 1) + (xcd - r) * q) + off; }
        const int nig = WGM * nN, gid = wgid / nig, fm = gid * WGM, gsz = (nM - fm) < WGM ? (nM - fm) : WGM;
        pm = fm + ((wgid % nig) % gsz); pn = (wgid % nig) / gsz; return true;
    }
};

typedef int i32x4 __attribute__((ext_vector_type(4)));
typedef int i32x8 __attribute__((ext_vector_type(8)));
__device__ __forceinline__ i32x8 cat8(bf16x8 a, bf16x8 b) { return __builtin_shufflevector(__builtin_bit_cast(i32x4, a), __builtin_bit_cast(i32x4, b), 0, 1, 2, 3, 4, 5, 6, 7); }
__device__ __forceinline__ unsigned cvt_pk_bf16(float lo, float hi) { unsigned r; asm volatile("v_cvt_pk_bf16_f32 %0, %1, %2" : "=v"(r) : "v"(lo), "v"(hi)); return r; }
__device__ __forceinline__ float bf_lo(unsigned w) { return __uint_as_float(w << 16); }
__device__ __forceinline__ float bf_hi(unsigned w) { return __uint_as_float(w & 0xffff0000u); }
__device__ __forceinline__ float sigmoid_f(float x) { return __builtin_amdgcn_rcpf(1.0f + __builtin_amdgcn_exp2f(-1.4426950408889634f * x)); }
__device__ __forceinline__ f32x2 sig2(f32x2 x) { const f32x2 t = x * (-1.4426950408889634f); f32x2 e; e.x = __builtin_amdgcn_exp2f(t.x); e.y = __builtin_amdgcn_exp2f(t.y); e = e + 1.0f; f32x2 r; r.x = __builtin_amdgcn_rcpf(e.x); r.y = __builtin_amdgcn_rcpf(e.y); return r; }
__device__ __forceinline__ f32x4 sig4(f32x4 x) { const f32x2 a = sig2((f32x2){x[0], x[1]}), b = sig2((f32x2){x[2], x[3]}); return (f32x4){a.x, a.y, b.x, b.y}; }
__device__ __forceinline__ float gelu_tanh_f(float x) { const float t = 0.7978845608028654f * (x + 0.044715f * x * x * x); return x * sigmoid_f(2.0f * t); }

template <class Epi, class Sched, bool GATHER = false, bool ALIGN_EPI = true, bool FP8 = false>
__device__ __forceinline__ void gemm_phase(PG8_LAS unsigned char* lds, const int KB  , const unsigned lda, const unsigned ldb, const Sched& S, const Epi& E) {
    int tid_ = threadIdx.x; asm volatile("" : "+v"(tid_));
    const int tid = tid_, wid = __builtin_amdgcn_readfirstlane(tid >> 6), lane = tid & 63, wr = wid >> 2, wc = wid & 3, fr = lane & 15, fq = lane >> 4;
    const int nt = KB / (BK * 2);
    unsigned voffA[2], voffB[2], colA[2]; int rowA[2];
#pragma unroll
    for (int i = 0; i < 2; ++i) { int R, C; stage_rc(tid * 16 + i * 8192, R, C); const int Rb = Epi::PERM ? ((R & ~31) + perm32(R & 31)) : R;
        voffA[i] = (unsigned)R * lda + (unsigned)C * 2u; voffB[i] = (unsigned)Rb * ldb + (unsigned)C * 2u; rowA[i] = R; colA[i] = (unsigned)C * 2u; }
    const size_t kstep = (size_t)(BK * 2);
    const size_t hstepA = (size_t)HALF * lda, hstepB = (size_t)HALF * ldb;
    const unsigned ldsw = (unsigned)wid * 1024u;
    const int aoff = lds_byte(wr * 64 + fr, fq * 8), boff = lds_byte(wc * 32 + fr, fq * 8);
    unsigned gofc[2][2], gofn[2][2];
#define PG8_SA(b, h) (((b) * 2 + (h)) * HTB)
#define PG8_SB(b, h) ((4 + (b) * 2 + (h)) * HTB)
#define PG8_STAGE_B(bufoff, kbase, h) do { _Pragma("unroll") for (int _i = 0; _i < 2; ++_i) \
        __builtin_amdgcn_global_load_lds((const unsigned*)((const char*)(kbase) + (h) * hstepB + voffB[_i]), (PG8_LAS unsigned*)(lds + (bufoff) + ldsw + _i * 8192), 16, 0, 0); } while (0)
#define PG8_STAGE_A(bufoff, kbase, h, NX) do { _Pragma("unroll") for (int _i = 0; _i < 2; ++_i) { \
        const char* _p; if constexpr (GATHER) _p = (const char*)(kbase) + ((NX) ? gofn[h][_i] : gofc[h][_i]); else _p = (const char*)(kbase) + (h) * hstepA + voffA[_i]; \
        __builtin_amdgcn_global_load_lds((const unsigned*)_p, (PG8_LAS unsigned*)(lds + (bufoff) + ldsw + _i * 8192), 16, 0, 0); } } while (0)
#define PG8_LDA(dst, b, h) do { _Pragma("unroll") for (int m = 0; m < 4; ++m) { const bf16x8 _x = *(const PG8_LAS bf16x8*)(lds + PG8_SA(b, h) + aoff + m * 2048), _y = *(const PG8_LAS bf16x8*)(lds + PG8_SA(b, h) + aoff + m * 2048 + 1024); \
        if constexpr (FP8) dst##8[m] = cat8(_x, _y); else { dst[m][0] = _x; dst[m][1] = _y; } } } while (0)
#define PG8_LDB(dst, b, h) do { _Pragma("unroll") for (int n = 0; n < 2; ++n) { const bf16x8 _x = *(const PG8_LAS bf16x8*)(lds + PG8_SB(b, h) + boff + n * 2048), _y = *(const PG8_LAS bf16x8*)(lds + PG8_SB(b, h) + boff + n * 2048 + 1024); \
        if constexpr (FP8) dst##8[n] = cat8(_x, _y); else { dst[n][0] = _x; dst[n][1] = _y; } } } while (0)
#define PG8_MMA(ai, bj, At, Bt) do { __builtin_amdgcn_s_setprio(1); _Pragma("unroll") for (int m = 0; m < 4; ++m) _Pragma("unroll") for (int n = 0; n < 2; ++n) { \
        if constexpr (FP8) asm volatile("v_mfma_f32_16x16x128_f8f6f4 %0, %1, %2, %0" : "+v"(acc[ai][bj][m][n]) : "v"(Bt##8[n]), "v"(At##8[m]));     \
        else { _Pragma("unroll") for (int k = 0; k < 2; ++k) acc[ai][bj][m][n] = __builtin_amdgcn_mfma_f32_16x16x32_bf16(Bt[n][k], At[m][k], acc[ai][bj][m][n], 0, 0, 0); } } __builtin_amdgcn_s_setprio(0); } while (0)
#define PG8_WAIT_V(n) asm volatile("s_waitcnt vmcnt(" #n ")" ::: "memory")
#define PG8_WAIT_L(n) asm volatile("s_waitcnt lgkmcnt(" #n ")" ::: "memory")
#define PG8_BAR __builtin_amdgcn_s_barrier()
#define PG8_SCHED __builtin_amdgcn_sched_barrier(0)
    Unit cur, nxt; int ui = 0;
    if (!S.next(0, cur)) return;
    if constexpr (GATHER) {
#pragma unroll
        for (int h = 0; h < 2; ++h)
#pragma unroll
            for (int i = 0; i < 2; ++i) { gofc[h][i] = (unsigned)cur.tok[rowA[i] + HALF * h] * lda + colA[i]; gofn[h][i] = gofc[h][i]; }
    }
    f32x4 acc[2][2][4][2];
#pragma unroll
    for (int a = 0; a < 2; ++a)
#pragma unroll
        for (int b = 0; b < 2; ++b)
#pragma unroll
            for (int m = 0; m < 4; ++m)
#pragma unroll
                for (int n = 0; n < 2; ++n) acc[a][b][m][n] = (f32x4){0.f, 0.f, 0.f, 0.f};
    bf16x8 At[4][2], B0[2][2], B1[2][2]; i32x8 At8[4], B08[2], B18[2];
    const char* cA = cur.A; const char* cB = cur.B;
    PG8_STAGE_B(PG8_SB(0, 0), cB, 0); PG8_STAGE_B(PG8_SB(0, 1), cB, 1); PG8_STAGE_A(PG8_SA(0, 0), cA, 0, false); PG8_STAGE_A(PG8_SA(0, 1), cA, 1, false);
    if (wr == 1) PG8_BAR;
    PG8_WAIT_V(2); PG8_BAR;
    PG8_STAGE_B(PG8_SB(1, 0), cB + kstep, 0); PG8_STAGE_A(PG8_SA(1, 0), cA + kstep, 0, false); PG8_STAGE_B(PG8_SB(1, 1), cB + kstep, 1);
    PG8_WAIT_V(6); PG8_BAR;
    for (;;) {
        const bool has_next = S.next(ui + 1, nxt);
        const char* nA = has_next ? nxt.A : cA; const char* nB = has_next ? nxt.B : cB;
        for (int t = 0; t < nt; t += 2) {
            const bool last = (t == nt - 2);
            const char* a1 = cA + (size_t)(t + 1) * kstep;
            const char* a2 = last ? nA : cA + (size_t)(t + 2) * kstep; const char* b2 = last ? nB : cB + (size_t)(t + 2) * kstep;
            const char* a3 = a2 + kstep; const char* b3 = b2 + kstep;
            if constexpr (GATHER) { if (last && has_next) {
#pragma unroll
                for (int h = 0; h < 2; ++h)
#pragma unroll
                    for (int i = 0; i < 2; ++i) gofn[h][i] = (unsigned)nxt.tok[rowA[i] + HALF * h] * lda + colA[i]; } }
            PG8_LDB(B0, 0, 0); PG8_LDB(B1, 0, 1); PG8_SCHED; PG8_LDA(At, 0, 0); PG8_STAGE_A(PG8_SA(1, 1), a1, 1, false);
            PG8_WAIT_V(8); PG8_WAIT_L(0); PG8_BAR; PG8_MMA(0, 0, At, B0); PG8_MMA(0, 1, At, B1); PG8_BAR; PG8_SCHED;
            PG8_LDA(At, 0, 1); PG8_STAGE_B(PG8_SB(0, 0), b2, 0); PG8_STAGE_B(PG8_SB(0, 1), b2, 1); PG8_STAGE_A(PG8_SA(0, 0), a2, 0, last);
            PG8_WAIT_V(8); PG8_WAIT_L(0); PG8_BAR; PG8_MMA(1, 0, At, B0); PG8_MMA(1, 1, At, B1); PG8_BAR; PG8_SCHED;
            PG8_LDB(B0, 1, 0); PG8_LDB(B1, 1, 1); PG8_SCHED; PG8_LDA(At, 1, 0); PG8_STAGE_A(PG8_SA(0, 1), a2, 1, last);
            PG8_WAIT_V(8); PG8_WAIT_L(0); PG8_BAR; PG8_MMA(0, 0, At, B0); PG8_MMA(0, 1, At, B1); PG8_BAR; PG8_SCHED;
            PG8_LDA(At, 1, 1); PG8_STAGE_B(PG8_SB(1, 0), b3, 0); PG8_STAGE_B(PG8_SB(1, 1), b3, 1); PG8_STAGE_A(PG8_SA(1, 0), a3, 0, last);
            PG8_WAIT_V(8); PG8_WAIT_L(0); PG8_BAR; PG8_MMA(1, 0, At, B0); PG8_MMA(1, 1, At, B1); PG8_BAR; PG8_SCHED;
        }
        if constexpr (ALIGN_EPI) { if (wr == 0) PG8_BAR; }
        if constexpr (FP8) {
            asm volatile("s_nop 15\n\ts_nop 7" : "+v"(acc[0][0][0][0]), "+v"(acc[0][0][0][1]), "+v"(acc[0][0][1][0]), "+v"(acc[0][0][1][1]), "+v"(acc[0][0][2][0]), "+v"(acc[0][0][2][1]), "+v"(acc[0][0][3][0]), "+v"(acc[0][0][3][1]),
                         "+v"(acc[0][1][0][0]), "+v"(acc[0][1][0][1]), "+v"(acc[0][1][1][0]), "+v"(acc[0][1][1][1]), "+v"(acc[0][1][2][0]), "+v"(acc[0][1][2][1]), "+v"(acc[0][1][3][0]), "+v"(acc[0][1][3][1]));
            asm volatile("" : "+v"(acc[1][0][0][0]), "+v"(acc[1][0][0][1]), "+v"(acc[1][0][1][0]), "+v"(acc[1][0][1][1]), "+v"(acc[1][0][2][0]), "+v"(acc[1][0][2][1]), "+v"(acc[1][0][3][0]), "+v"(acc[1][0][3][1]),
                         "+v"(acc[1][1][0][0]), "+v"(acc[1][1][0][1]), "+v"(acc[1][1][1][0]), "+v"(acc[1][1][1][1]), "+v"(acc[1][1][2][0]), "+v"(acc[1][1][2][1]), "+v"(acc[1][1][3][0]), "+v"(acc[1][1][3][1])); }
        E(acc, cur, wr, wc, fr, fq);
        if (!has_next) break;
#pragma unroll
        for (int a = 0; a < 2; ++a)
#pragma unroll
            for (int b = 0; b < 2; ++b)
#pragma unroll
                for (int m = 0; m < 4; ++m)
#pragma unroll
                    for (int n = 0; n < 2; ++n) acc[a][b][m][n] = (f32x4){0.f, 0.f, 0.f, 0.f};
        cur = nxt; cA = nA; cB = nB; ++ui;
        if constexpr (GATHER) {
#pragma unroll
            for (int h = 0; h < 2; ++h)
#pragma unroll
                for (int i = 0; i < 2; ++i) gofc[h][i] = gofn[h][i];
        }
        if constexpr (ALIGN_EPI) { if (wr == 1) PG8_BAR; }
    }
    PG8_WAIT_V(0);
    if constexpr (!ALIGN_EPI) { if (wr == 0) PG8_BAR; }
    PG8_BAR;
#undef PG8_SA
#undef PG8_SB
#undef PG8_STAGE_A
#undef PG8_STAGE_B
#undef PG8_LDA
#undef PG8_LDB
#undef PG8_MMA
#undef PG8_WAIT_V
#undef PG8_WAIT_L
#undef PG8_BAR
#undef PG8_SCHED
}
}

constexpr size_t MiB = 1u << 20;
constexpr size_t WS_CTL = 0, CTL_ZERO_BYTES = 64 * 1024;
constexpr size_t WS_SELE = 1 * MiB;
constexpr size_t WS_SELW = WS_SELE + 64 * 1024;
constexpr size_t WS_CNTG = WS_SELW + 128 * 1024;
constexpr size_t WS_ROWTOK = WS_CNTG + 8 * 1024;
constexpr size_t WS_ROWW = WS_ROWTOK + 160 * 1024;
constexpr size_t WS_TOKPOS = WS_ROWW + 160 * 1024;
constexpr size_t WS_AT = WS_TOKPOS + 128 * 1024;
static_assert(WS_AT + 32 * 1024 <= 4 * MiB, "tables");
constexpr size_t WS_WMGU = 4 * MiB;
constexpr size_t WS_WMD = 60 * MiB;
constexpr size_t WS_HN = 88 * MiB;
constexpr size_t WS_ACT = 120 * MiB;
constexpr size_t WS_BB = WS_ACT;
constexpr size_t WS_UC = WS_ACT + 32 * MiB;
constexpr size_t WS_UB = WS_ACT + 64 * MiB;
constexpr size_t WS_GC = WS_ACT + 84 * MiB;
constexpr size_t WS_GS = WS_ACT + 116 * MiB;
constexpr size_t WS_HID = WS_ACT;
constexpr size_t WS_MOEO = 240 * MiB;
constexpr size_t WS_WDGU = 268 * MiB;
constexpr size_t WS_WDD = 282 * MiB;
constexpr size_t WS_BTY = 289 * MiB;
constexpr size_t WS_BTS = 329 * MiB;
constexpr size_t WS_WIN = 338 * MiB;
constexpr size_t WS_WCO = 360 * MiB, WS_WGLU = 364 * MiB, WS_WO = 368 * MiB;
constexpr size_t WS_XB = 372 * MiB;
constexpr size_t WS_SSQ = 404 * MiB;
constexpr size_t WS_END = 405 * MiB;
static_assert(WS_HID + (size_t)MOE_ROWS * DFF <= WS_MOEO && WS_MOEO + (size_t)MOE_ROWS * D * 2 <= WS_END && WS_GS + 32 * MiB <= WS_WDGU, "map: the MoE buffers overlay the mixer activations and non-MoE weight copies (all dead by then)");
constexpr int CW_BAR = 1024;

constexpr int RING_BYTES = 131072, TAB_OFF = RING_BYTES;
constexpr int T_MISC = TAB_OFF;
constexpr int T_SELE = TAB_OFF + 128;
constexpr int T_SELW = T_SELE + 256;
constexpr int T_PEXP = T_SELW + 512;
constexpr int T_TOT = T_PEXP + 4 * (MOE_PANELS + 8);
constexpr int T_BIAS = 133120;
constexpr int T_RSTD = T_BIAS + 4 * PW;
constexpr int T_RMAP = T_RSTD + 4096;
constexpr int LDS_BYTES = 163840;
static_assert(T_TOT + 128 <= T_BIAS && T_RMAP + 16 <= LDS_BYTES, "LDS map");

#define GAS __attribute__((address_space(1)))
#define LAS __attribute__((address_space(3)))
typedef unsigned short bf16;
typedef unsigned v4u __attribute__((ext_vector_type(4)));
typedef unsigned v2u __attribute__((ext_vector_type(2)));
typedef float f32x4 __attribute__((ext_vector_type(4)));
typedef float f32x2 __attribute__((ext_vector_type(2)));
#define LDS_WAIT() asm volatile("s_waitcnt lgkmcnt(0)" ::: "memory")
using pg8::cvt_pk_bf16; using pg8::bf_lo; using pg8::bf_hi; using pg8::sigmoid_f; using pg8::gelu_tanh_f; using pg8::sig4;

#define XB_TMO      128
#define XB_XCNT(j)  (256  + 64 * (j))
#define XB_XSUB(j)  (1280 + 64 * (j))
#define XB_XGEN(j)  (2304 + 64 * (j))
#define XB_TOP      3328
#define XB_TOPGEN   3392
#define XCD_BAR_WORDS 3456
#define XB_SPIN_CAP (1u << 18)
__device__ __forceinline__ unsigned xb_ld(unsigned* p)              { return __hip_atomic_load(p, __ATOMIC_RELAXED, __HIP_MEMORY_SCOPE_AGENT); }
__device__ __forceinline__ unsigned xb_add(unsigned* p, unsigned v) { return __hip_atomic_fetch_add(p, v, __ATOMIC_RELAXED, __HIP_MEMORY_SCOPE_AGENT); }
__device__ __forceinline__ unsigned xb_xcc_id() { return (unsigned)__builtin_amdgcn_s_getreg((3 << 11) | 20) & 0xFu; }
#define XB_SPIN(cond, bar) do { unsigned _sp = 0; while (cond) { __builtin_amdgcn_s_sleep(1); \
    if ((++_sp & 255u) == 0u) { if (xb_ld(&(bar)[XB_TMO])) break; if (_sp > XB_SPIN_CAP) { atomicAdd(&(bar)[XB_TMO], 1u); break; } } } } while (0)
struct XcdBarrier { unsigned* bar; unsigned x; volatile LAS unsigned* st; };
__device__ __forceinline__ XcdBarrier xcd_barrier_post(unsigned* bar, volatile LAS unsigned* st) {
    XcdBarrier b; b.bar = bar; b.x = xb_xcc_id(); b.st = st;
    if (threadIdx.x == 0) (void)xb_add(&bar[XB_XCNT(b.x)], 1u);
    return b;
}
__device__ __forceinline__ void xcd_barrier_complete(unsigned* bar, unsigned x, unsigned& nloc, unsigned& nx) {
    const unsigned G = gridDim.x * gridDim.y * gridDim.z;
    unsigned sum, cnt, mine, sp = 0u;
    for (;;) {
        sum = 0u; cnt = 0u; mine = 0u;
#pragma unroll
        for (unsigned j = 0; j < 16; ++j) { const unsigned c = xb_ld(&bar[XB_XCNT(j)]); sum += c; cnt += (c > 0u) ? 1u : 0u; mine = (j == x) ? c : mine; }
        if (sum == G) break;
        __builtin_amdgcn_s_sleep(1);
        if ((++sp & 255u) == 0u) { if (xb_ld(&bar[XB_TMO])) break; if (sp > XB_SPIN_CAP) { atomicAdd(&bar[XB_TMO], 1u); break; } }
    }
    nloc = mine > 0u ? mine : 1u; nx = cnt > 0u ? cnt : 1u;
}
__device__ __forceinline__ void xcd_barrier(const XcdBarrier& b) {
    asm volatile("s_waitcnt vmcnt(0)" ::: "memory");
    __syncthreads();
    if (threadIdx.x == 0) {
        unsigned* bar = b.bar;
        __builtin_amdgcn_s_waitcnt(0);
        unsigned nloc = b.st[0], nx = b.st[1];
        if (nloc == 0u) { xcd_barrier_complete(bar, b.x, nloc, nx); b.st[0] = nloc; b.st[1] = nx; }
        const unsigned old = xb_add(&bar[XB_XSUB(b.x)], 1u);
        const unsigned gen = old / nloc;
        if (old + 1u == (gen + 1u) * nloc) {
            __builtin_amdgcn_fence(__ATOMIC_RELEASE, "agent");
            asm volatile("s_waitcnt vmcnt(0)" ::: "memory");
            const unsigned og = xb_add(&bar[XB_TOP], 1u);
            const unsigned tg = og / nx;
            if (og + 1u == (tg + 1u) * nx) xb_add(&bar[XB_TOPGEN], 1u);
            else XB_SPIN(xb_ld(&bar[XB_TOPGEN]) == tg, bar);
            __builtin_amdgcn_fence(__ATOMIC_ACQUIRE, "agent");
            xb_add(&bar[XB_XGEN(b.x)], 1u);
            asm volatile("s_waitcnt vmcnt(0)" ::: "memory");
        } else {
            XB_SPIN(xb_ld(&bar[XB_XGEN(b.x)]) == gen, bar);
            __builtin_amdgcn_fence(__ATOMIC_ACQUIRE, "agent");
            asm volatile("s_waitcnt vmcnt(0)" ::: "memory");
        }
    }
    __syncthreads();
}

struct Frame {
    LAS unsigned char* lds;
    int tid, lane, wave, bid, vcu, G;
    unsigned char* ws;
};
typedef const void* kcvp_t;
__device__ __forceinline__ const void* karg_ptr(int off) { const __attribute__((address_space(4))) char* b = (const __attribute__((address_space(4))) char*)__builtin_amdgcn_kernarg_segment_ptr(); asm volatile("" : "+s"(b)); return *(const __attribute__((address_space(4))) kcvp_t*)(b + off); }
#define KIN(i) ((const float*)karg_ptr(8 * (i)))
#define KOUT ((float*)karg_ptr(208))
#define KWS ((unsigned char*)karg_ptr(216))
#define MKFRAME(F) Frame F; { int t_ = threadIdx.x; asm volatile("" : "+v"(t_)); F.lds = (LAS unsigned char*)lds_raw; F.tid = t_; F.lane = t_ & 63; F.wave = __builtin_amdgcn_readfirstlane(t_ >> 6); \
    { int g_ = gridDim.x, b_ = blockIdx.x; asm volatile("" : "+s"(g_), "+s"(b_)); F.G = g_; F.bid = b_; } F.vcu = (F.G % 8 == 0) ? (F.bid % 8) * (F.G / 8) + F.bid / 8 : F.bid; F.ws = KWS; }

__device__ __forceinline__ float wave_sum(float v) {
#pragma unroll
    for (int o = 1; o < 64; o <<= 1) v += __shfl_xor(v, o);
    return v;
}

__device__ __forceinline__ void prep_rstd(Frame& F, const pg8::Order& o, const float* SSQ) {
    LAS int* map = (LAS int*)(F.lds + T_RMAP); LAS float* rl = (LAS float*)(F.lds + T_RSTD);
    int p0 = -1, p1 = -1, p2 = -1, p3 = -1, np = 0;
    for (int i = 0; ; ++i) { int pm, pn; if (!o.tile(i, pm, pn)) break;
        if (pm == p0 || pm == p1 || pm == p2 || pm == p3) continue;
        if (np == 0) p0 = pm; else if (np == 1) p1 = pm; else if (np == 2) p2 = pm; else if (np == 3) p3 = pm;
        ++np; }
    if (F.tid == 0) { map[0] = p0; map[1] = p1; map[2] = p2; map[3] = p3; }
#pragma unroll
    for (int it = 0; it < 2; ++it) { const int sl = 2 * it + (F.tid >> 8); const int ps = sl == 0 ? p0 : sl == 1 ? p1 : sl == 2 ? p2 : p3;
        if (ps >= 0) { const int t = F.tid & 255; const f32x4* p = (const f32x4*)(SSQ + (size_t)(ps * 256 + t) * 16); const f32x4 a = p[0], b = p[1], c = p[2], d = p[3];
            const float q = ((a[0] + a[1]) + (a[2] + a[3])) + ((b[0] + b[1]) + (b[2] + b[3])) + ((c[0] + c[1]) + (c[2] + c[3])) + ((d[0] + d[1]) + (d[2] + d[3]));
            rl[sl * 256 + t] = 1.0f / sqrtf(q * (1.0f / D) + RMS_EPS); } }
    __syncthreads();
}
__device__ __forceinline__ void prep_bias(Frame& F, const float* bias) {
    LAS float* bl = (LAS float*)(F.lds + T_BIAS);
    for (int i = F.tid; i < PW; i += 512) bl[i] = bias[i];
    __syncthreads();
}
struct SchedPlain {
    pg8::Order o; const char* A; const char* B; size_t tA, tB;
    __device__ __forceinline__ bool next(int i, pg8::Unit& u) const { int pm, pn; if (!o.tile(i, pm, pn)) return false; u.pm = pm; u.pn = pn; u.aux = 0; u.A = A + (size_t)pm * tA; u.B = B + (size_t)pn * tB; u.tok = nullptr; return true; }
};
struct SchedSsmY {
    pg8::Order o; const char* UB; const char* BTY;
    __device__ __forceinline__ bool next(int i, pg8::Unit& u) const { int pm, pnn; if (!o.tile(i, pm, pnn)) return false; const int g = pnn >> 1; u.pm = pm; u.pn = pnn & 1; u.aux = g;
        u.A = UB + (size_t)pm * 256 * (NG * KY * 2) + (size_t)g * (KY * 2); u.B = BTY + (size_t)pnn * 256 * (KY * 2); u.tok = nullptr; return true; }
};
struct SchedSsmS {
    pg8::Order o; const char* UB; const char* BTS;
    __device__ __forceinline__ bool next(int i, pg8::Unit& u) const { int pm, g; if (!o.tile(i, pm, g)) return false; u.pm = pm; u.pn = 0; u.aux = g;
        u.A = UB + (size_t)pm * 256 * (NG * KY * 2) + (size_t)g * (KY * 2); u.B = BTS + (size_t)g * 128 * (512 * 2); u.tok = nullptr; return true; }
};
struct SchedMoe1 {
    pg8::Order o; const char* HN; const char* W; const int* rowtok; const LAS int* pexp;
    __device__ __forceinline__ bool next(int i, pg8::Unit& u) const { int pm, pn; if (!o.tile(i, pm, pn)) return false; const int e = pexp[pm]; u.pm = pm; u.pn = pn; u.aux = e;
        u.A = HN; u.B = W + (size_t)e * (2 * DFF) * D + (size_t)pn * 256 * D; u.tok = rowtok + pm * 256; return true; }
};
struct SchedMoe2 {
    pg8::Order o; const char* HID; const char* W; const LAS int* pexp;
    __device__ __forceinline__ bool next(int i, pg8::Unit& u) const { int pm, pn; if (!o.tile(i, pm, pn)) return false; const int e = pexp[pm]; u.pm = pm; u.pn = pn; u.aux = e;
        u.A = HID + (size_t)pm * 256 * DFF; u.B = W + (size_t)e * D * DFF + (size_t)pn * 256 * DFF; u.tok = nullptr; return true; }
};

using pg8::Unit; using pg8::HALF; using pg8::BM;
typedef const f32x4 (&AccRef)[2][2][4][2];
constexpr int HN_SH = 4, WGU_SH = 7, HID_SH = 3, WD_SH = 8;
__device__ __forceinline__ float clamp8(float v) { return __builtin_fminf(__builtin_fmaxf(v, -440.0f), 440.0f); }
__device__ __forceinline__ unsigned pk4_fp8(float a, float b, float c, float d) { unsigned w = 0u; w = (unsigned)__builtin_amdgcn_cvt_pk_fp8_f32(a, b, (int)w, false); w = (unsigned)__builtin_amdgcn_cvt_pk_fp8_f32(c, d, (int)w, true); return w; }
__device__ __forceinline__ v4u pack8(const f32x4 a, const f32x4 b) { v4u w; w.x = cvt_pk_bf16(a[0], a[1]); w.y = cvt_pk_bf16(a[2], a[3]); w.z = cvt_pk_bf16(b[0], b[1]); w.w = cvt_pk_bf16(b[2], b[3]); return w; }
__device__ __forceinline__ void unpack8(const v4u w, f32x4& a, f32x4& b) { a = (f32x4){bf_lo(w.x), bf_hi(w.x), bf_lo(w.y), bf_hi(w.y)}; b = (f32x4){bf_lo(w.z), bf_hi(w.z), bf_lo(w.w), bf_hi(w.w)}; }

__device__ __forceinline__ void row_rstd(const float* SSQ, const LAS unsigned char* lds, int pm, int rloc, float (&rs)[2][4]) {
    const LAS int* map = (const LAS int*)(lds + T_RMAP); const LAS float* rl = (const LAS float*)(lds + T_RSTD);
    const int sl = map[0] == pm ? 0 : map[1] == pm ? 1 : map[2] == pm ? 2 : map[3] == pm ? 3 : -1;
    if (sl >= 0) {
#pragma unroll
        for (int ai = 0; ai < 2; ++ai)
#pragma unroll
            for (int m = 0; m < 4; ++m) rs[ai][m] = rl[sl * 256 + rloc + ai * HALF + m * 16];
    } else {
#pragma unroll
        for (int ai = 0; ai < 2; ++ai)
#pragma unroll
            for (int m = 0; m < 4; ++m) { const f32x4* p = (const f32x4*)(SSQ + (size_t)(pm * BM + rloc + ai * HALF + m * 16) * 16); const f32x4 a = p[0], b = p[1], c = p[2], d = p[3];
                const float t = ((a[0] + a[1]) + (a[2] + a[3])) + ((b[0] + b[1]) + (b[2] + b[3])) + ((c[0] + c[1]) + (c[2] + c[3])) + ((d[0] + d[1]) + (d[2] + d[3]));
                rs[ai][m] = 1.0f / sqrtf(t * (1.0f / D) + RMS_EPS); }
    }
}
struct EpiProj {
    static constexpr bool PERM = true;
    bf16* BB; bf16* UC; bf16* UB; bf16* GC; bf16* GS; const LAS unsigned char* lds; const float* SSQ;
    __device__ __forceinline__ void operator()(AccRef acc, const Unit& u, int wr, int wc, int fr, int fq) const {
        const int row0 = u.pm * BM + wr * 64 + fr, cl = wc * 32 + 8 * fq, pn = u.pn;
        float rs[2][4]; row_rstd(SSQ, lds, u.pm, wr * 64 + fr, rs); const LAS float* bias = (const LAS float*)(lds + T_BIAS);
        if (pn >= 4 && pn < 12) {
            const int q = pn - 4, ch = 128 * q + cl;
            const f32x4 bc0 = *(const LAS f32x4*)(bias + 1024 + ch), bc1 = *(const LAS f32x4*)(bias + 1024 + ch + 4), bv0 = *(const LAS f32x4*)(bias + 2048 + ch), bv1 = *(const LAS f32x4*)(bias + 2048 + ch + 4);
#pragma unroll
            for (int ai = 0; ai < 2; ++ai)
#pragma unroll
                for (int m = 0; m < 4; ++m) { const int row = row0 + ai * HALF + m * 16;
                    const float r = rs[ai][m]; const f32x4 p0 = (acc[ai][0][m][0] * r + bc0) * (acc[ai][1][m][0] * r + bv0), p1 = (acc[ai][0][m][1] * r + bc1) * (acc[ai][1][m][1] * r + bv1);
                    *(v4u*)(UC + (size_t)row * D + ch) = pack8(p0, p1); }
            return;
        }
#pragma unroll
        for (int bj = 0; bj < 2; ++bj) {
            const int dcol = pn * BM + bj * HALF + cl;
            const f32x4 b0 = *(const LAS f32x4*)(bias + dcol), b1 = *(const LAS f32x4*)(bias + dcol + 4);
#pragma unroll
            for (int ai = 0; ai < 2; ++ai)
#pragma unroll
                for (int m = 0; m < 4; ++m) { const int row = row0 + ai * HALF + m * 16;
                    f32x4 v0 = acc[ai][bj][m][0] * rs[ai][m] + b0, v1 = acc[ai][bj][m][1] * rs[ai][m] + b1;
                    if (pn < 4) { *(v4u*)(BB + (size_t)row * D + dcol) = pack8(v0, v1); }
                    else if (pn < 14) { const int cu = dcol - 3072, g = cu >> 4, cp = cu & 15;
                        *(v4u*)(UB + ((size_t)(row >> 5) * NG + g) * KY + (row & 31) * 16 + cp) = pack8(v0, v1); }
                    else {
                        v0 = sig4(v0); v1 = sig4(v1);
                        if (pn < 18) *(v4u*)(GC + (size_t)row * D + (dcol - 3584)) = pack8(v0, v1);
                        else *(v4u*)(GS + (size_t)row * D + (dcol - 4608)) = pack8(v0, v1); } }
        }
    }
};
struct EpiSloc {
    static constexpr bool PERM = false;
    float* SL;
    __device__ __forceinline__ void operator()(AccRef acc, const Unit& u, int wr, int wc, int fr, int fq) const {
        const int row0 = u.pm * BM + wr * 64 + fr, col0 = wc * 32 + 4 * fq;
#pragma unroll
        for (int ai = 0; ai < 2; ++ai)
#pragma unroll
            for (int m = 0; m < 4; ++m) { float* p = SL + ((size_t)(row0 + ai * HALF + m * 16) * NG + u.aux) * 128 + col0;
#pragma unroll
                for (int n = 0; n < 2; ++n) *(f32x4*)(p + n * 16) = acc[ai][0][m][n]; }
    }
};
struct EpiY {
    static constexpr bool PERM = true;
    bf16* YB; const bf16* UB; const float* dsk;
    __device__ __forceinline__ void operator()(AccRef acc, const Unit& u, int wr, int wc, int fr, int fq) const {
        const int row0 = u.pm * BM + wr * 64 + fr, g = u.aux;
#pragma unroll
        for (int bj = 0; bj < 2; ++bj) {
            const int col = u.pn * BM + bj * HALF + wc * 32 + 8 * fq, j = col >> 4, c = col & 15, ch = g * 16 + c;
            const f32x4 d0 = *(const f32x4*)(dsk + ch), d1 = *(const f32x4*)(dsk + ch + 4);
#pragma unroll
            for (int ai = 0; ai < 2; ++ai)
#pragma unroll
                for (int m = 0; m < 4; ++m) { const int chunk = row0 + ai * HALF + m * 16;
                    const v4u uw = *(const v4u*)(UB + ((size_t)chunk * NG + g) * KY + j * 16 + c); f32x4 u0, u1; unpack8(uw, u0, u1);
                    f32x4 v0 = acc[ai][bj][m][0] + d0 * u0, v1 = acc[ai][bj][m][1] + d1 * u1;
#pragma unroll
                    for (int k = 0; k < 4; ++k) { v0[k] = gelu_tanh_f(v0[k]); v1[k] = gelu_tanh_f(v1[k]); }
                    *(v4u*)(YB + ((size_t)chunk * TCH + j) * DSSM + ch) = pack8(v0, v1); }
        }
    }
};
struct EpiConvOut {
    static constexpr bool PERM = true;
    bf16* GC;
    __device__ __forceinline__ void operator()(AccRef acc, const Unit& u, int wr, int wc, int fr, int fq) const {
        const int row0 = u.pm * BM + wr * 64 + fr;
#pragma unroll
        for (int ai = 0; ai < 2; ++ai)
#pragma unroll
            for (int m = 0; m < 4; ++m)
#pragma unroll
                for (int bj = 0; bj < 2; ++bj) { bf16* p = GC + (size_t)(row0 + ai * HALF + m * 16) * D + u.pn * BM + bj * HALF + wc * 32 + 8 * fq;
                    f32x4 g0, g1; unpack8(*(const v4u*)p, g0, g1); *(v4u*)p = pack8(g0 * acc[ai][bj][m][0], g1 * acc[ai][bj][m][1]); }
    }
};
struct EpiGlu {
    static constexpr bool PERM = true;
    bf16* P1; const bf16* GS;
    __device__ __forceinline__ void operator()(AccRef acc, const Unit& u, int wr, int wc, int fr, int fq) const {
        const int row0 = u.pm * BM + wr * 64 + fr, ch = u.pn * HALF + wc * 32 + 8 * fq;
#pragma unroll
        for (int ai = 0; ai < 2; ++ai)
#pragma unroll
            for (int m = 0; m < 4; ++m) { const size_t off = (size_t)(row0 + ai * HALF + m * 16) * D + ch;
                f32x4 p0, p1, s0, s1; unpack8(*(const v4u*)(P1 + off), p0, p1); unpack8(*(const v4u*)(GS + off), s0, s1);
                f32x4 z0 = acc[ai][0][m][0], z1 = acc[ai][0][m][1]; const f32x4 y0 = acc[ai][1][m][0], y1 = acc[ai][1][m][1];
                z0 = p0 + s0 * z0 * sig4(y0); z1 = p1 + s1 * z1 * sig4(y1);
                *(v4u*)(P1 + off) = pack8(z0, z1); }
    }
};
struct EpiRes {
    static constexpr bool PERM = true;
    bf16* XB; float* SSQ;
    __device__ __forceinline__ void operator()(AccRef acc, const Unit& u, int wr, int wc, int fr, int fq) const {
        const int row0 = u.pm * BM + wr * 64 + fr, col0 = u.pn * BM + wc * 32 + 8 * fq;
#pragma unroll
        for (int ai = 0; ai < 2; ++ai)
#pragma unroll
            for (int m = 0; m < 4; ++m) { const int row = row0 + ai * HALF + m * 16; float s = 0.f;
#pragma unroll
                for (int bj = 0; bj < 2; ++bj) { bf16* p = XB + (size_t)row * D + col0 + bj * HALF; f32x4 x0, x1; unpack8(*(const v4u*)p, x0, x1);
                    x0 += acc[ai][bj][m][0]; x1 += acc[ai][bj][m][1]; *(v4u*)p = pack8(x0, x1);
                    s += ((x0[0] * x0[0] + x0[1] * x0[1]) + (x0[2] * x0[2] + x0[3] * x0[3])) + ((x1[0] * x1[0] + x1[1] * x1[1]) + (x1[2] * x1[2] + x1[3] * x1[3])); }
                s += __shfl_xor(s, 16); s += __shfl_xor(s, 32);
                if (fq == 0) SSQ[(size_t)row * 16 + u.pn * 4 + wc] = s; }
    }
};
struct EpiSwiglu {
    static constexpr bool PERM = true;
    bf16* H; const float* SSQ; const LAS unsigned char* lds;
    __device__ __forceinline__ void operator()(AccRef acc, const Unit& u, int wr, int wc, int fr, int fq) const {
        const int row0 = u.pm * BM + wr * 64 + fr, ch = u.pn * HALF + wc * 32 + 8 * fq;
        float rs[2][4]; row_rstd(SSQ, lds, u.pm, wr * 64 + fr, rs);
#pragma unroll
        for (int ai = 0; ai < 2; ++ai)
#pragma unroll
            for (int m = 0; m < 4; ++m) { const float r = rs[ai][m], r2 = r * r; f32x4 g0 = acc[ai][0][m][0], g1 = acc[ai][0][m][1]; const f32x4 u0 = acc[ai][1][m][0], u1 = acc[ai][1][m][1];
                g0 = (g0 * u0) * (sig4(g0 * r) * r2); g1 = (g1 * u1) * (sig4(g1 * r) * r2);
                *(v4u*)(H + (size_t)(row0 + ai * HALF + m * 16) * DFF + ch) = pack8(g0, g1); }
    }
};
struct EpiSwiglu8 {
    static constexpr bool PERM = true;
    unsigned char* H;
    __device__ __forceinline__ void operator()(AccRef acc, const Unit& u, int wr, int wc, int fr, int fq) const {
        const int row0 = u.pm * BM + wr * 64 + fr, ch = u.pn * HALF + wc * 32 + 8 * fq; const float sc = (float)(1 << HID_SH) / (float)(1 << (HN_SH + WGU_SH)), si = 1.0f / (float)(1 << (HN_SH + WGU_SH));
#pragma unroll
        for (int ai = 0; ai < 2; ++ai)
#pragma unroll
            for (int m = 0; m < 4; ++m) { f32x4 g0 = acc[ai][0][m][0], g1 = acc[ai][0][m][1]; const f32x4 u0 = acc[ai][1][m][0], u1 = acc[ai][1][m][1];
                g0 = (g0 * u0) * (sig4(g0 * si) * (sc * si)); g1 = (g1 * u1) * (sig4(g1 * si) * (sc * si));
#pragma unroll
                for (int k = 0; k < 4; ++k) { g0[k] = clamp8(g0[k]); g1[k] = clamp8(g1[k]); }
                v2u w; w.x = pk4_fp8(g0[0], g0[1], g0[2], g0[3]); w.y = pk4_fp8(g1[0], g1[1], g1[2], g1[3]);
                *(v2u*)(H + (size_t)(row0 + ai * HALF + m * 16) * DFF + ch) = w; }
    }
};
struct EpiMoeDown {
    static constexpr bool PERM = true;
    bf16* O; const float* roww;
    __device__ __forceinline__ void operator()(AccRef acc, const Unit& u, int wr, int wc, int fr, int fq) const {
        const int row0 = u.pm * BM + wr * 64 + fr;
#pragma unroll
        for (int ai = 0; ai < 2; ++ai)
#pragma unroll
            for (int m = 0; m < 4; ++m) { const int row = row0 + ai * HALF + m * 16; const float w = roww[row] * (1.0f / (float)(1 << (HID_SH + WD_SH)));
#pragma unroll
                for (int bj = 0; bj < 2; ++bj) *(v4u*)(O + (size_t)row * D + u.pn * BM + bj * HALF + wc * 32 + 8 * fq) = pack8(acc[ai][bj][m][0] * w, acc[ai][bj][m][1] * w); }
    }
};

template <bool FP8> __device__ __forceinline__ void tr_item2(const float* W, int N, int k0, int n0, unsigned char* dst, size_t ld_bytes, int drow0, float scale, LAS unsigned* scr, int lane, const float* gk = nullptr) {
    unsigned dw[32];
    const float* src = W + (size_t)k0 * N + n0 + lane;
    if constexpr (FP8) {
#pragma unroll
        for (int hlf = 0; hlf < 2; ++hlf) { float v[64];
#pragma unroll
            for (int i = 0; i < 64; ++i) v[i] = src[(size_t)(hlf * 64 + i) * N];
#pragma unroll
            for (int i = 0; i < 16; ++i) dw[hlf * 16 + i] = pk4_fp8(v[4 * i] * scale, v[4 * i + 1] * scale, v[4 * i + 2] * scale, v[4 * i + 3] * scale); }
    } else { float v[64];
#pragma unroll
        for (int i = 0; i < 64; ++i) v[i] = src[(size_t)i * N];
        if (gk) {
#pragma unroll
            for (int i = 0; i < 64; ++i) v[i] *= gk[k0 + i]; }
#pragma unroll
        for (int i = 0; i < 32; ++i) dw[i] = cvt_pk_bf16(v[2 * i], v[2 * i + 1]); }
#pragma unroll
    for (int i = 0; i < 8; ++i) *(LAS v4u*)(scr + lane * 36 + 4 * i) = (v4u){dw[4 * i], dw[4 * i + 1], dw[4 * i + 2], dw[4 * i + 3]};
    LDS_WAIT(); asm volatile("" ::: "memory");
    const int c = lane & 7; const size_t kb = (size_t)k0 * (FP8 ? 1 : 2);
#pragma unroll
    for (int j = 0; j < 8; ++j) { const int r = (lane >> 3) + 8 * j; const v4u o = *(const LAS v4u*)(scr + r * 36 + 4 * c);
        *(GAS v4u*)(dst + (size_t)(drow0 + r) * ld_bytes + kb + 16 * c) = o; }
    LDS_WAIT(); asm volatile("" ::: "memory");
}
__device__ __forceinline__ int pair_row(int ch, int second) { return (ch >> 7) * 256 + (ch & 127) + (second ? 128 : 0); }
__device__ __forceinline__ void p0_transposes(Frame& F) {
    LAS unsigned* scr = (LAS unsigned*)(F.lds + 49152 + F.wave * 9216);
    const int gw = F.vcu * 8 + F.wave, NGW = F.G * 8;
    constexpr int I_MGU = 8 * 56, I_MD = 28 * 16;
    constexpr int I_IN = 16 * 88, I_SQ = 16 * 16, I_GLU = 8 * 32, I_GU = 16 * 56, I_DN = 56 * 16;
    constexpr int N8 = 8 * (2 * I_MGU + I_MD), NIT = N8 + 2 * I_IN + 2 * I_SQ + 2 * I_GLU + 2 * I_SQ + 2 * I_GU + I_DN;
    unsigned char* ws = F.ws;
    for (int it = gw; it < NIT; it += NGW) {
        int r = it;
        if (r < N8) { const int e = r / (2 * I_MGU + I_MD); r %= (2 * I_MGU + I_MD);
            if (r < 2 * I_MGU) { const int sgu = r / I_MGU; r %= I_MGU; const int n0 = (r % 56) * 64;
                tr_item2<true>((sgu ? KIN(23) : KIN(22)) + (size_t)e * D * DFF, DFF, (r / 56) * 128, n0, ws + WS_WMGU + (size_t)e * 2 * DFF * D, D, pair_row(n0, sgu), (float)(1 << WGU_SH), scr, F.lane); }
            else { r -= 2 * I_MGU; tr_item2<true>(KIN(24) + (size_t)e * DFF * D, D, (r / 16) * 128, (r % 16) * 64, ws + WS_WMD + (size_t)e * D * DFF, DFF, (r % 16) * 64, (float)(1 << WD_SH), scr, F.lane); }
            continue; }
        r -= N8;
        if (r < 2 * I_IN) { const int l = r / I_IN; r %= I_IN; const int n0 = (r % 88) * 64; int d = n0;
            if (n0 >= 1024 && n0 < 2048) d = 1024 + pair_row(n0 - 1024, 0); else if (n0 >= 2048 && n0 < 3072) d = 1024 + pair_row(n0 - 2048, 1);
            tr_item2<false>(KIN(2) + (size_t)l * D * PW, PW, (r / 88) * 64, n0, ws + WS_WIN + (size_t)l * PW * D * 2, D * 2, d, 1.f, scr, F.lane, KIN(1) + l * D); continue; }
        r -= 2 * I_IN;
        if (r < 2 * I_SQ) { const int l = r / I_SQ; r %= I_SQ; tr_item2<false>(KIN(5) + (size_t)l * D * D, D, (r / 16) * 64, (r % 16) * 64, ws + WS_WCO + (size_t)l * D * D * 2, D * 2, (r % 16) * 64, 1.f, scr, F.lane); continue; }
        r -= 2 * I_SQ;
        if (r < 2 * I_GLU) { const int l = r / I_GLU; r %= I_GLU; const int n0 = (r % 32) * 64; const int d = n0 < 1024 ? pair_row(n0, 0) : pair_row(n0 - 1024, 1);
            tr_item2<false>(KIN(14) + (size_t)l * DSSM * 2048, 2048, (r / 32) * 64, n0, ws + WS_WGLU + (size_t)l * 2048 * DSSM * 2, DSSM * 2, d, 1.f, scr, F.lane); continue; }
        r -= 2 * I_GLU;
        if (r < 2 * I_SQ) { const int l = r / I_SQ; r %= I_SQ; tr_item2<false>(KIN(15) + (size_t)l * D * D, D, (r / 16) * 64, (r % 16) * 64, ws + WS_WO + (size_t)l * D * D * 2, D * 2, (r % 16) * 64, 1.f, scr, F.lane); continue; }
        r -= 2 * I_SQ;
        if (r < 2 * I_GU) { const int sgu = r / I_GU; r %= I_GU; const int n0 = (r % 56) * 64;
            tr_item2<false>(sgu ? KIN(18) : KIN(17), DFF, (r / 56) * 64, n0, ws + WS_WDGU, D * 2, pair_row(n0, sgu), 1.f, scr, F.lane, KIN(16)); continue; }
        r -= 2 * I_GU;
        tr_item2<false>(KIN(19), D, (r / 16) * 64, (r % 16) * 64, ws + WS_WDD, DFF * 2, (r % 16) * 64, 1.f, scr, F.lane);
    }
}
__device__ __forceinline__ void p0_ssm_job(Frame& F, int l, int g, int cq) {
    LAS f32x2* pw = (LAS f32x2*)(F.lds);
    LAS f32x2* bbL = pw + 33 * 64;
    LAS f32x2* CL = bbL + 64 * 16;
    LAS float* KmL = (LAS float*)(CL + 16 * 64);
    const int t = F.tid, lg = l * NG + g;
    const float* a_re = KIN(6); const float* a_im = KIN(7); const float* ldt = KIN(8); const float* b_re = KIN(9); const float* b_im = KIN(10); const float* c_re = KIN(11); const float* c_im = KIN(12);
    for (int idx = t; idx < 1024; idx += 512) CL[idx] = (f32x2){c_re[(size_t)lg * 1024 + idx], c_im[(size_t)lg * 1024 + idx]};
    if (t < 64) {
        const int n = t; const float ar = a_re[lg * 64 + n], ai = a_im[lg * 64 + n], dt = expf(ldt[lg]);
        const float mag = expf(ar * dt), ang = ai * dt; float sn, cs; sn = sinf(ang); cs = cosf(ang);
        const float are = mag * cs, aim = mag * sn, den = ar * ar + ai * ai, nr = are - 1.0f, ni = aim;
        const float cre = (nr * ar + ni * ai) / den, cim = (ni * ar - nr * ai) / den;
        float pr = 1.0f, pi = 0.0f; pw[n] = (f32x2){1.0f, 0.0f};
        for (int d = 1; d <= TCH; ++d) { const float qr = pr * are - pi * aim, qi = pr * aim + pi * are; pr = qr; pi = qi; pw[d * 64 + n] = (f32x2){pr, pi}; }
        if (cq == 0) ((f32x2*)(F.ws + WS_AT))[lg * 64 + n] = (f32x2){pr, pi};
#pragma unroll
        for (int c = 0; c < 16; ++c) { const float br = b_re[((size_t)lg * 64 + n) * 16 + c], bi = b_im[((size_t)lg * 64 + n) * 16 + c]; bbL[n * 16 + c] = (f32x2){cre * br - cim * bi, cre * bi + cim * br}; }
    }
    __syncthreads();
    { const int cp = t & 15, cc = (t >> 4) & 3, dq = t >> 6;
#pragma unroll
      for (int r = 0; r < 4; ++r) { const int d = dq * 4 + r; float s = 0.f;
          for (int n = 0; n < 64; ++n) { const f32x2 C = CL[(4 * cq + cc) * 64 + n], p = pw[d * 64 + n], b = bbL[n * 16 + cp];
              const float xr = C.x * p.x - C.y * p.y, xi = C.x * p.y + C.y * p.x; s += xr * b.x - xi * b.y; }
          KmL[(d * 4 + cc) * 16 + cp] = s; } }
    __syncthreads();
    const int q = F.lane, i = q >> 1, c0 = (q & 1) * 8;
    for (int rr = F.wave; rr < 128; rr += 8) {
        const int j = rr >> 2, cc = rr & 3, c = 4 * cq + cc;
        bf16* dst = (bf16*)(F.ws + WS_BTY) + ((size_t)lg * 512 + j * 16 + c) * KY;
        float v[8];
#pragma unroll
        for (int e = 0; e < 8; ++e) v[e] = (i <= j) ? KmL[((j - i) * 4 + cc) * 16 + c0 + e] : 0.0f;
        v4u o; o.x = cvt_pk_bf16(v[0], v[1]); o.y = cvt_pk_bf16(v[2], v[3]); o.z = cvt_pk_bf16(v[4], v[5]); o.w = cvt_pk_bf16(v[6], v[7]);
        *(GAS v4u*)(dst + q * 8) = o;
        if (q < 16) { const int part = q >> 3, n0 = (q & 7) * 8;
#pragma unroll
            for (int e = 0; e < 8; ++e) { const f32x2 C = CL[c * 64 + n0 + e], p = pw[(j + 1) * 64 + n0 + e]; v[e] = part ? -(C.x * p.y + C.y * p.x) : (C.x * p.x - C.y * p.y); }
            o.x = cvt_pk_bf16(v[0], v[1]); o.y = cvt_pk_bf16(v[2], v[3]); o.z = cvt_pk_bf16(v[4], v[5]); o.w = cvt_pk_bf16(v[6], v[7]);
            *(GAS v4u*)(dst + 512 + q * 8) = o; }
    }
    for (int rr = F.wave * 4; rr < F.wave * 4 + 4; ++rr) {
        const int part = rr >> 4, n = 16 * cq + (rr & 15);
        bf16* dst = (bf16*)(F.ws + WS_BTS) + ((size_t)lg * 128 + part * 64 + n) * 512;
        const f32x2 p = pw[(TCH - 1 - i) * 64 + n]; float v[8];
#pragma unroll
        for (int e = 0; e < 8; ++e) { const f32x2 b = bbL[n * 16 + c0 + e]; v[e] = part ? (p.x * b.y + p.y * b.x) : (p.x * b.x - p.y * b.y); }
        v4u o; o.x = cvt_pk_bf16(v[0], v[1]); o.y = cvt_pk_bf16(v[2], v[3]); o.z = cvt_pk_bf16(v[4], v[5]); o.w = cvt_pk_bf16(v[6], v[7]);
        *(GAS v4u*)(dst + q * 8) = o;
    }
    __syncthreads();
}

__device__ __forceinline__ void t_xcvt(Frame& F, const float* X, bf16* XB, float* SSQ) {
    const int gw = F.vcu * 8 + F.wave, NGW = F.G * 8;
    for (int m = gw; m < M; m += NGW) {
        const f32x4* xr = (const f32x4*)(X + (size_t)m * D) + F.lane; f32x4 v[4]; float s = 0.f;
#pragma unroll
        for (int j = 0; j < 4; ++j) { v[j] = xr[64 * j]; s += (v[j][0] * v[j][0] + v[j][1] * v[j][1]) + (v[j][2] * v[j][2] + v[j][3] * v[j][3]); }
        s = wave_sum(s);
        v2u* o = (v2u*)(XB + (size_t)m * D) + F.lane;
#pragma unroll
        for (int j = 0; j < 4; ++j) { v2u w; w.x = cvt_pk_bf16(v[j][0], v[j][1]); w.y = cvt_pk_bf16(v[j][2], v[j][3]); o[64 * j] = w; }
        if (F.lane < 16) SSQ[(size_t)m * 16 + F.lane] = F.lane == 0 ? s : 0.f;
    }
}
__device__ __forceinline__ void t_norm_router(Frame& F, const bf16* X, const float* gvec, bf16* HN, const float* rw, const float* rb) {
    f32x4 g[4]; f32x4 rwv[4][4][2];
#pragma unroll
    for (int j = 0; j < 4; ++j) { g[j] = ((const f32x4*)gvec)[F.lane + 64 * j];
#pragma unroll
        for (int c = 0; c < 4; ++c) { const f32x4* p = (const f32x4*)(rw + (size_t)(4 * (F.lane + 64 * j) + c) * NE); rwv[j][c][0] = p[0]; rwv[j][c][1] = p[1]; } }
    LAS int* selE = (LAS int*)(F.lds + T_SELE); LAS float* selW = (LAS float*)(F.lds + T_SELW);
    for (int k = 0; k < 8; ++k) {
        const int tl = F.wave * 8 + k, m = F.bid * 64 + tl;
        const v2u* xr = (const v2u*)(X + (size_t)m * D) + F.lane; f32x4 v[4]; float s = 0.f;
#pragma unroll
        for (int j = 0; j < 4; ++j) { const v2u a = xr[64 * j]; v[j] = (f32x4){bf_lo(a.x), bf_hi(a.x), bf_lo(a.y), bf_hi(a.y)}; s += (v[j][0] * v[j][0] + v[j][1] * v[j][1]) + (v[j][2] * v[j][2] + v[j][3] * v[j][3]); }
        const float rstd = 1.0f / sqrtf(wave_sum(s) * (1.0f / D) + RMS_EPS);
        unsigned* o = (unsigned*)((unsigned char*)HN + (size_t)m * D) + F.lane; const float hsc = (float)(1 << HN_SH);
        float lg[8];
#pragma unroll
        for (int e = 0; e < 8; ++e) lg[e] = 0.f;
#pragma unroll
        for (int j = 0; j < 4; ++j) { const f32x4 y = v[j] * rstd * g[j]; o[64 * j] = pk4_fp8(clamp8(y[0] * hsc), clamp8(y[1] * hsc), clamp8(y[2] * hsc), clamp8(y[3] * hsc));
#pragma unroll
            for (int c = 0; c < 4; ++c)
#pragma unroll
                for (int e = 0; e < 8; ++e) lg[e] += y[c] * rwv[j][c][e >> 2][e & 3]; }
#pragma unroll
        for (int e = 0; e < 8; ++e) lg[e] = wave_sum(lg[e]) + rb[e];
        int e0 = 0; float v0 = lg[0];
#pragma unroll
        for (int e = 1; e < 8; ++e) if (lg[e] > v0) { v0 = lg[e]; e0 = e; }
        int e1 = -1; float v1 = -3.0e38f;
#pragma unroll
        for (int e = 0; e < 8; ++e) if (e != e0 && lg[e] > v1) { v1 = lg[e]; e1 = e; }
        const float w0 = 1.0f / (1.0f + expf(v1 - v0)), w1 = 1.0f - w0;
        if (F.lane == 0) { selE[tl] = e0 | (e1 << 4); selW[tl * 2] = w0; selW[tl * 2 + 1] = w1;
            ((int*)(F.ws + WS_SELE))[m] = e0 | (e1 << 4); ((float*)(F.ws + WS_SELW))[2 * m] = w0; ((float*)(F.ws + WS_SELW))[2 * m + 1] = w1; }
    }
    __syncthreads();
    if (F.tid < 8) { int c = 0; for (int i = 0; i < 64; ++i) { const int se = selE[i]; c += ((se & 15) == F.tid || (se >> 4) == F.tid) ? 1 : 0; } ((int*)(F.ws + WS_CNTG))[F.bid * 8 + F.tid] = c; }
}
__device__ __forceinline__ void build_panels(Frame& F) {
    LAS int* cn = (LAS int*)F.lds;
    LAS int* pexp = (LAS int*)(F.lds + T_PEXP); LAS int* tt = (LAS int*)(F.lds + T_TOT);
    const int* cg = (const int*)(F.ws + WS_CNTG);
    for (int i = F.tid; i < F.G * 8; i += 512) cn[i] = cg[i];
    __syncthreads();
    if (F.tid < 8) { int tot = 0, off = 0; for (int b = 0; b < F.G; ++b) { const int c = cn[b * 8 + F.tid]; tot += c; off += (b < F.bid) ? c : 0; } tt[F.tid] = tot; tt[8 + F.tid] = off; }
    __syncthreads();
    if (F.tid == 0) { int p = 0; for (int e = 0; e < 8; ++e) { const int np = (tt[e] + 255) >> 8; tt[16 + e] = p * 256; tt[24 + e] = np; for (int k = 0; k < np; ++k) pexp[p + k] = e; p += np; } pexp[MOE_PANELS] = p; }
    __syncthreads();
}
__device__ __forceinline__ void t_perm(Frame& F) {
    build_panels(F);
    LAS int* selE = (LAS int*)(F.lds + T_SELE); LAS float* selW = (LAS float*)(F.lds + T_SELW); LAS int* tt = (LAS int*)(F.lds + T_TOT);
    if (F.tid < 64) selE[F.tid] = ((const int*)(F.ws + WS_SELE))[F.bid * 64 + F.tid];
    if (F.tid < 128) selW[F.tid] = ((const float*)(F.ws + WS_SELW))[F.bid * 128 + F.tid];
    __syncthreads();
    int* rowtok = (int*)(F.ws + WS_ROWTOK); float* roww = (float*)(F.ws + WS_ROWW); int* tokpos = (int*)(F.ws + WS_TOKPOS);
    if (F.tid < 8) { const int e = F.tid; int pos = tt[16 + e] + tt[8 + e];
        for (int i = 0; i < 64; ++i) { const int se = selE[i]; const int slot = ((se & 15) == e) ? 0 : (((se >> 4) == e) ? 1 : -1);
            if (slot >= 0) { const int m = F.bid * 64 + i; rowtok[pos] = m; roww[pos] = selW[i * 2 + slot]; tokpos[m * 2 + slot] = pos; ++pos; } } }
    if (F.bid < 8 && F.tid >= 64 && F.tid < 320) { const int e = F.bid, r = tt[e] + (F.tid - 64); if (r < tt[24 + e] * 256) { rowtok[tt[16 + e] + r] = 0; roww[tt[16 + e] + r] = 0.f; } }
}
__device__ __forceinline__ void t_conv(Frame& F, bf16* BB, const bf16* UC, const float* cw, int rank, int nranks) {
    if (rank < 0) return;
    const int gt = rank * 512 + F.tid, NT = nranks * 512, c8 = (gt & 127) * 8;
    f32x4 w[3][2];
#pragma unroll
    for (int k = 0; k < 3; ++k) { w[k][0] = *(const f32x4*)(cw + k * D + c8); w[k][1] = *(const f32x4*)(cw + k * D + c8 + 4); }
    for (int idx = gt; idx < M * 128; idx += NT) {
        const int m = idx >> 7, tpos = m & (SEQ - 1); const size_t off = (size_t)m * D + c8;
        f32x4 a0, a1, x0, x1; unpack8(*(const v4u*)(UC + off), x0, x1); a0 = w[2][0] * x0; a1 = w[2][1] * x1;
        if (tpos >= 1) { unpack8(*(const v4u*)(UC + off - D), x0, x1); a0 += w[1][0] * x0; a1 += w[1][1] * x1; }
        if (tpos >= 2) { unpack8(*(const v4u*)(UC + off - 2 * D), x0, x1); a0 += w[0][0] * x0; a1 += w[0][1] * x1; }
        unpack8(*(const v4u*)(BB + off), x0, x1);
        *(v4u*)(BB + off) = pack8(a0 * x0, a1 * x1);
    }
}
__device__ __forceinline__ void t_carry4(Frame& F, int l, int pm, int g, const float* SL, bf16* UB) {
    LAS float* sl = (LAS float*)F.lds;
#pragma unroll
    for (int j = 0; j < 16; ++j) { const int i4 = F.tid + 512 * j, ck = i4 >> 5, q = i4 & 31;
        *(LAS f32x4*)(sl + i4 * 4) = *(const f32x4*)(SL + ((size_t)(pm * 256 + ck) * NG + g) * 128 + 4 * q); }
    __syncthreads();
    if (F.wave < 4) { const int n = F.lane, bb = F.wave; const f32x2 a = ((const f32x2*)(F.ws + WS_AT))[(l * NG + g) * 64 + n]; float sr = 0.f, si = 0.f;
        for (int k = 0; k < 64; ++k) { const int ck = bb * 64 + k; bf16* dst = UB + ((size_t)(pm * 256 + ck) * NG + g) * KY + 512;
            const unsigned pr = cvt_pk_bf16(sr, si); dst[n] = (bf16)(pr & 0xffffu); dst[64 + n] = (bf16)(pr >> 16);
            const float lr = sl[ck * 128 + n], li = sl[ck * 128 + 64 + n]; const float nr = a.x * sr - a.y * si + lr, ni = a.x * si + a.y * sr + li; sr = nr; si = ni; } }
    __syncthreads();
}
__device__ __forceinline__ void t_combine_final(Frame& F, const bf16* XB, float* OUT, const bf16* O, const float* gvec) {
    const int gw = F.vcu * 8 + F.wave, NGW = F.G * 8; const int* tokpos = (const int*)(F.ws + WS_TOKPOS);
    f32x4 g[4];
#pragma unroll
    for (int j = 0; j < 4; ++j) g[j] = ((const f32x4*)gvec)[F.lane + 64 * j];
    for (int m = gw; m < M; m += NGW) {
        const int p0 = tokpos[2 * m], p1 = tokpos[2 * m + 1];
        f32x4* xr = (f32x4*)(OUT + (size_t)m * D) + F.lane; const v2u* xb = (const v2u*)(XB + (size_t)m * D) + F.lane; const v2u* o0 = (const v2u*)(O + (size_t)p0 * D) + F.lane; const v2u* o1 = (const v2u*)(O + (size_t)p1 * D) + F.lane;
        f32x4 v[4]; float s = 0.f;
#pragma unroll
        for (int j = 0; j < 4; ++j) { const v2u a = o0[64 * j], b = o1[64 * j];
            const v2u c = xb[64 * j];
            v[j] = (f32x4){bf_lo(c.x), bf_hi(c.x), bf_lo(c.y), bf_hi(c.y)} + (f32x4){bf_lo(a.x), bf_hi(a.x), bf_lo(a.y), bf_hi(a.y)} + (f32x4){bf_lo(b.x), bf_hi(b.x), bf_lo(b.y), bf_hi(b.y)};
            s += (v[j][0] * v[j][0] + v[j][1] * v[j][1]) + (v[j][2] * v[j][2] + v[j][3] * v[j][3]); }
        const float rstd = 1.0f / sqrtf(wave_sum(s) * (1.0f / D) + RMS_EPS);
#pragma unroll
        for (int j = 0; j < 4; ++j) xr[64 * j] = v[j] * rstd * g[j];
    }
}

#ifndef PHMASK
#define PHMASK 0xFFFFFFFFu
#endif
#define EN(k) ((PHMASK >> (k)) & 1u)
#ifndef DUPMASK
#define DUPMASK 0u
#endif
#define REP(k) for (int rep_ = 0; rep_ < 1 + (int)((DUPMASK >> (k)) & 1u); ++rep_)
#define IN(p) (lo <= (p) && (p) < hi)
#define SEAM(p) do { if (multi && (p) + 1 < hi) xcd_barrier(bar); } while (0)
#define RING ((LAS unsigned char*)lds_raw)
template <int L> __device__ __forceinline__ void layer_phases(const int lo0, const int hi0, const bool multi, const XcdBarrier& bar, unsigned char* lds_raw) {
    constexpr int l = L;
    int lo = lo0, hi = hi0, G = gridDim.x, cidx = blockIdx.x; asm volatile("" : "+s"(lo), "+s"(hi), "+s"(G), "+s"(cidx));
    {
        const int pb = 1 + 16 * l;
        if (IN(pb + 1) && EN(2)) REP(2) {
            unsigned char* ws = KWS;
            SchedPlain S; S.o.init(M / 256, PW / 256, G, cidx); S.A = (const char*)(ws + WS_XB); S.B = (const char*)(ws + WS_WIN) + (size_t)l * PW * D * 2; S.tA = (size_t)256 * D * 2; S.tB = (size_t)256 * D * 2;
            EpiProj E{(bf16*)(ws + WS_BB), (bf16*)(ws + WS_UC), (bf16*)(ws + WS_UB), (bf16*)(ws + WS_GC), (bf16*)(ws + WS_GS), RING, (const float*)(ws + WS_SSQ)};
            { MKFRAME(F); prep_rstd(F, S.o, (const float*)(ws + WS_SSQ)); prep_bias(F, KIN(3) + (size_t)l * PW); }
            pg8::gemm_phase<EpiProj, SchedPlain, false, true>(RING, D * 2, D * 2, D * 2, S, E);
            { int pm_, pn_; if (!S.o.tile(5, pm_, pn_)) { MKFRAME(F); __syncthreads(); for (int job = cidx - 128; job >= 0 && job < NG * 4; job += 128) p0_ssm_job(F, l, job >> 2, job & 3); } }
            SEAM(pb + 1);
        }
        if (IN(pb + 2) && EN(3)) REP(3) {
            unsigned char* ws = KWS;
            { SchedSsmS S; S.o.init(2, NG, G, cidx); S.UB = (const char*)(ws + WS_UB); S.BTS = (const char*)(ws + WS_BTS) + (size_t)l * NG * 128 * 512 * 2;
              EpiSloc E{(float*)(ws + WS_HN + 16 * MiB)};
              pg8::gemm_phase<EpiSloc, SchedSsmS, false, true>(RING, 512 * 2, NG * KY * 2, 512 * 2, S, E);
              { int pm_, g_; if (S.o.tile(0, pm_, g_)) { MKFRAME(F); t_carry4(F, l, pm_, g_, (const float*)(F.ws + WS_HN + 16 * MiB), (bf16*)(F.ws + WS_UB)); } } }
            { MKFRAME(F); t_conv(F, (bf16*)(F.ws + WS_BB), (const bf16*)(F.ws + WS_UC), KIN(4) + (size_t)l * 3 * D, G == 256 ? cidx - 64 : cidx, G == 256 ? 192 : G); }
            SEAM(pb + 2);
        }
        if (IN(pb + 4) && EN(5)) REP(5) {
            { unsigned char* ws = KWS;
              SchedSsmY S; S.o.init(2, 2 * NG, G, cidx); S.UB = (const char*)(ws + WS_UB); S.BTY = (const char*)(ws + WS_BTY) + (size_t)l * NG * 512 * KY * 2;
              EpiY E{(bf16*)(ws + WS_HN), (const bf16*)(ws + WS_UB), KIN(13) + (size_t)l * DSSM};
              pg8::gemm_phase<EpiY, SchedSsmY, false, true>(RING, KY * 2, NG * KY * 2, KY * 2, S, E); }
            { unsigned char* ws = KWS;
              SchedPlain S; S.o.init(M / 256, D / 256, G, cidx); S.A = (const char*)(ws + WS_BB); S.B = (const char*)(ws + WS_WCO) + (size_t)l * D * D * 2; S.tA = (size_t)256 * D * 2; S.tB = (size_t)256 * D * 2;
              EpiConvOut E{(bf16*)(ws + WS_GC)};
              pg8::gemm_phase<EpiConvOut, SchedPlain, false, true>(RING, D * 2, D * 2, D * 2, S, E); }
            SEAM(pb + 4);
        }
        if (IN(pb + 5) && EN(6)) REP(6) {
            unsigned char* ws = KWS;
            SchedPlain S; S.o.init(M / 256, 2048 / 256, G, cidx); S.A = (const char*)(ws + WS_HN); S.B = (const char*)(ws + WS_WGLU) + (size_t)l * 2048 * DSSM * 2; S.tA = (size_t)256 * DSSM * 2; S.tB = (size_t)256 * DSSM * 2;
            EpiGlu E{(bf16*)(ws + WS_GC), (const bf16*)(ws + WS_GS)};
            pg8::gemm_phase<EpiGlu, SchedPlain, false, true>(RING, DSSM * 2, DSSM * 2, DSSM * 2, S, E);
            SEAM(pb + 5);
        }
        if (IN(pb + 6) && EN(7)) REP(7) {
            unsigned char* ws = KWS;
            SchedPlain S; S.o.init(M / 256, D / 256, G, cidx); S.A = (const char*)(ws + WS_GC); S.B = (const char*)(ws + WS_WO) + (size_t)l * D * D * 2; S.tA = (size_t)256 * D * 2; S.tB = (size_t)256 * D * 2;
            EpiRes E{(bf16*)(ws + WS_XB), (float*)(ws + WS_SSQ)};
            pg8::gemm_phase<EpiRes, SchedPlain, false, true>(RING, D * 2, D * 2, D * 2, S, E);
            SEAM(pb + 6);
        }
        if (IN(pb + 7) && EN(8) && L == 1) REP(8) {
            MKFRAME(F);
            t_norm_router(F, (const bf16*)(F.ws + WS_XB), KIN(16) + D, (bf16*)(F.ws + WS_HN), KIN(20), KIN(21));
            SEAM(pb + 7);
        }
        if constexpr (L == 0) {
            if (IN(pb + 9) && EN(10)) REP(10) {
                unsigned char* ws = KWS;
                SchedPlain S; S.o.init(M / 256, 2 * DFF / 256, G, cidx); S.A = (const char*)(ws + WS_XB); S.B = (const char*)(ws + WS_WDGU); S.tA = (size_t)256 * D * 2; S.tB = (size_t)256 * D * 2;
                EpiSwiglu E{(bf16*)(ws + WS_HID), (const float*)(ws + WS_SSQ), RING};
                { MKFRAME(F); prep_rstd(F, S.o, (const float*)(ws + WS_SSQ)); }
                pg8::gemm_phase<EpiSwiglu, SchedPlain, false, true>(RING, D * 2, D * 2, D * 2, S, E);
                SEAM(pb + 9);
            }
            if (IN(pb + 10) && EN(11)) REP(11) {
                unsigned char* ws = KWS;
                SchedPlain S; S.o.init(M / 256, D / 256, G, cidx); S.A = (const char*)(ws + WS_HID); S.B = (const char*)(ws + WS_WDD); S.tA = (size_t)256 * DFF * 2; S.tB = (size_t)256 * DFF * 2;
                EpiRes E{(bf16*)(ws + WS_XB), (float*)(ws + WS_SSQ)};
                pg8::gemm_phase<EpiRes, SchedPlain, false, true>(RING, DFF * 2, DFF * 2, DFF * 2, S, E);
                SEAM(pb + 10);
            }
        } else {
            if (IN(pb + 8) && EN(9)) { MKFRAME(F); t_perm(F); SEAM(pb + 8); }
            const LAS int* pexp = (const LAS int*)(RING + T_PEXP);
            if (IN(pb + 9) && EN(12)) REP(12) {
                if (lo > pb + 8) { MKFRAME(F); build_panels(F); }
                unsigned char* ws = KWS;
                SchedMoe1 S; S.o.init(pexp[MOE_PANELS], 2 * DFF / 256, G, cidx); S.HN = (const char*)(ws + WS_HN); S.W = (const char*)(ws + WS_WMGU); S.rowtok = (const int*)(ws + WS_ROWTOK); S.pexp = pexp;
                EpiSwiglu8 E{(unsigned char*)(ws + WS_HID)};
                pg8::gemm_phase<EpiSwiglu8, SchedMoe1, true, true, true>(RING, D, D, D, S, E);
                SEAM(pb + 9);
            }
            if (IN(pb + 10) && EN(13)) REP(13) {
                if (lo > pb + 8) { MKFRAME(F); build_panels(F); }
                unsigned char* ws = KWS;
                SchedMoe2 S; S.o.init(pexp[MOE_PANELS], D / 256, G, cidx); S.HID = (const char*)(ws + WS_HID); S.W = (const char*)(ws + WS_WMD); S.pexp = pexp;
                EpiMoeDown E{(bf16*)(ws + WS_MOEO), (const float*)(ws + WS_ROWW)};
                pg8::gemm_phase<EpiMoeDown, SchedMoe2, false, true, true>(RING, DFF, DFF, DFF, S, E);
                SEAM(pb + 10);
            }
            if (IN(pb + 11) && EN(14)) { MKFRAME(F); t_combine_final(F, (const bf16*)(F.ws + WS_XB), KOUT, (const bf16*)(F.ws + WS_MOEO), KIN(25)); }
        }
    }
}
struct Args { const float* in[26]; float* out; unsigned char* ws; int ph_lo, ph_hi; };
constexpr int N_PHASES = 1 + 32;
__global__ void __launch_bounds__(512, 2) fwd_kernel(Args args) {
    extern __shared__ __attribute__((aligned(16))) unsigned char lds_raw[];
    const int lo0 = args.ph_lo, hi0 = args.ph_hi; const bool multi = (hi0 - lo0) > 1;
    volatile LAS unsigned* MISC = (volatile LAS unsigned*)((LAS unsigned char*)lds_raw + T_MISC);
    if (threadIdx.x < 32) MISC[threadIdx.x] = 0u;
    __syncthreads();
    XcdBarrier bar; bar.bar = (unsigned*)(KWS + WS_CTL) + CW_BAR; bar.x = 0; bar.st = MISC + 8;
    if (multi) bar = xcd_barrier_post((unsigned*)(KWS + WS_CTL) + CW_BAR, MISC + 8);
    int lo = lo0, hi = hi0, G = gridDim.x, cidx = blockIdx.x;

    if (IN(0) && EN(0)) REP(0) {
        MKFRAME(F); unsigned char* ws = F.ws;
        p0_transposes(F);
        t_xcvt(F, KIN(0), (bf16*)(ws + WS_XB), (float*)(ws + WS_SSQ));
        SEAM(0);
    }
    layer_phases<0>(lo0, hi0, multi, bar, lds_raw);
    layer_phases<1>(lo0, hi0, multi, bar, lds_raw);
#undef IN
#undef REP
#undef EN
#undef SEAM
#undef RING
}

extern "C" void kernel_launch(void* const* d_in, const int* in_sizes, int n_in, void* d_out, int out_size, void* d_ws, size_t ws_size, hipStream_t stream) {
    static int grid = 0;
    if (grid == 0) {
        if (n_in != 26 || in_sizes[0] != M * D || out_size != M * D || ws_size < WS_END) { fprintf(stderr, "kernel_launch: unexpected shapes / workspace (%zu < %zu)\n", ws_size, (size_t)WS_END); grid = -1; return; }
        int dev = 0, cus = 0;
        if (hipGetDevice(&dev) != hipSuccess || hipDeviceGetAttribute(&cus, hipDeviceAttributeMultiprocessorCount, dev) != hipSuccess) { grid = -1; return; }
        if (hipFuncSetAttribute((const void*)fwd_kernel, hipFuncAttributeMaxDynamicSharedMemorySize, LDS_BYTES) != hipSuccess) { grid = -1; return; }
        (void)hipGetLastError();
        grid = 256;
        if (cus < 256) { fprintf(stderr, "kernel_launch: needs 256 CUs, device has %d\n", cus); grid = -1; return; }
    }
    if (grid < 0) return;
    Args a{};
    for (int i = 0; i < 26; ++i) a.in[i] = (const float*)d_in[i];
    a.out = (float*)d_out; a.ws = (unsigned char*)d_ws;
#if MK_PER_PHASE
    static const int phases[] = {0, 2, 3, 5, 6, 7, 10, 11, 18, 19, 21, 22, 23, 24, 25, 26, 27, 28};
    for (int p : phases) {
        if (p == 1) continue;
        a.ph_lo = p; a.ph_hi = p + 1;
        hipLaunchKernelGGL(fwd_kernel, dim3(grid), dim3(512), LDS_BYTES, stream, a);
    }
#else
    (void)hipMemsetAsync((char*)d_ws + WS_CTL, 0, CTL_ZERO_BYTES, stream);
    a.ph_lo = 0; a.ph_hi = N_PHASES;
    hipLaunchKernelGGL(fwd_kernel, dim3(grid), dim3(512), LDS_BYTES, stream, a);
#endif
}
```

```cpp
#include <hip/hip_runtime.h>
#include <cstdio>
#include <cstdint>

#ifndef MK_PER_PHASE
#define MK_PER_PHASE 0
#endif

constexpr int M = 16384, D = 1024, SEQ = 2048, PW = 5632, DFF = 3584, NE = 8, DSSM = 512;
constexpr int TCH = 32, NCH = M / TCH, NG = 32, KY = 640;
constexpr int MOE_ROWS = 34816, MOE_PANELS = 136;
constexpr float RMS_EPS = 1e-6f;

namespace pg8 {
#define PG8_LAS __attribute__((address_space(3)))
typedef unsigned short bf16_t;
typedef short bf16x8 __attribute__((ext_vector_type(8)));
typedef float f32x4 __attribute__((ext_vector_type(4)));
typedef float f32x2 __attribute__((ext_vector_type(2)));
typedef unsigned u32x4 __attribute__((ext_vector_type(4)));
typedef unsigned u32x2 __attribute__((ext_vector_type(2)));
constexpr int BM = 256, BK = 64, HALF = 128, HTB = HALF * BK * 2, STAGE_BYTES = 8 * HTB, NXCD = 8, WGM = 4;

__host__ __device__ __forceinline__ int lds_byte(int r, int c) { const int st = (r >> 4) * 2 + (c >> 5), rr = r & 15, cc = c & 31, ob = rr * 64 + cc * 2; return st * 1024 + (ob ^ (((ob >> 9) & 1) << 5)); }
__host__ __device__ __forceinline__ void stage_rc(int b, int& R, int& C) { const int st = b / 1024, sb = b % 1024, swz = sb ^ (((sb >> 9) & 1) << 5); R = (st >> 1) * 16 + swz / 64; C = (st & 1) * 32 + (swz % 64) / 2; }
__host__ __device__ __forceinline__ int perm32(int rho) { const int n = rho >> 4, i = rho & 15; return 8 * (i >> 2) + 4 * n + (i & 3); }

struct Unit { int pm, pn, aux; const char* A; const char* B; const int* tok; };

struct Order {
    int nM, nN, nwg, G, c;
    __device__ __forceinline__ void init(int nM_, int nN_, int G_, int c_) { nM = nM_; nN = nN_; nwg = nM * nN; G = G_; c = c_; }
    __device__ __forceinline__ bool tile(int i, int& pm, int& pn) const {
        const long L = (long)i * G + c; if (L >= nwg) return false;
        int wgid = (int)L; { const int q = nwg / NXCD, r = nwg % NXCD, xcd = wgid % NXCD, off = wgid / NXCD; wgid = (xcd < r ? xcd * (q + 1) : r * (q + 1) + (xcd - r) * q) + off; }
        const int nig = WGM * nN, gid = wgid / nig, fm = gid * WGM, gsz = (nM - fm) < WGM ? (nM - fm) : WGM;
        pm = fm + ((wgid % nig) % gsz); pn = (wgid % nig) / gsz; return true;
    }
};

typedef int i32x4 __attribute__((ext_vector_type(4)));
typedef int i32x8 __attribute__((ext_vector_type(8)));
__device__ __forceinline__ i32x8 cat8(bf16x8 a, bf16x8 b) { return __builtin_shufflevector(__builtin_bit_cast(i32x4, a), __builtin_bit_cast(i32x4, b), 0, 1, 2, 3, 4, 5, 6, 7); }
__device__ __forceinline__ unsigned cvt_pk_bf16(float lo, float hi) { unsigned r; asm volatile("v_cvt_pk_bf16_f32 %0, %1, %2" : "=v"(r) : "v"(lo), "v"(hi)); return r; }
__device__ __forceinline__ float bf_lo(unsigned w) { return __uint_as_float(w << 16); }
__device__ __forceinline__ float bf_hi(unsigned w) { return __uint_as_float(w & 0xffff0000u); }
__device__ __forceinline__ float sigmoid_f(float x) { return __builtin_amdgcn_rcpf(1.0f + __builtin_amdgcn_exp2f(-1.4426950408889634f * x)); }
__device__ __forceinline__ f32x2 sig2(f32x2 x) { const f32x2 t = x * (-1.4426950408889634f); f32x2 e; e.x = __builtin_amdgcn_exp2f(t.x); e.y = __builtin_amdgcn_exp2f(t.y); e = e + 1.0f; f32x2 r; r.x = __builtin_amdgcn_rcpf(e.x); r.y = __builtin_amdgcn_rcpf(e.y); return r; }
__device__ __forceinline__ f32x4 sig4(f32x4 x) { const f32x2 a = sig2((f32x2){x[0], x[1]}), b = sig2((f32x2){x[2], x[3]}); return (f32x4){a.x, a.y, b.x, b.y}; }
__device__ __forceinline__ float gelu_tanh_f(float x) { const float t = 0.7978845608028654f * (x + 0.044715f * x * x * x); return x * sigmoid_f(2.0f * t); }

template <class Epi, class Sched, bool GATHER = false, bool ALIGN_EPI = true, bool FP8 = false>
__device__ __forceinline__ void gemm_phase(PG8_LAS unsigned char* lds, const int KB  , const unsigned lda, const unsigned ldb, const Sched& S, const Epi& E) {
    int tid_ = threadIdx.x; asm volatile("" : "+v"(tid_));
    const int tid = tid_, wid = __builtin_amdgcn_readfirstlane(tid >> 6), lane = tid & 63, wr = wid >> 2, wc = wid & 3, fr = lane & 15, fq = lane >> 4;
    const int nt = KB / (BK * 2);
    unsigned voffA[2], voffB[2], colA[2]; int rowA[2];
#pragma unroll
    for (int i = 0; i < 2; ++i) { int R, C; stage_rc(tid * 16 + i * 8192, R, C); const int Rb = Epi::PERM ? ((R & ~31) + perm32(R & 31)) : R;
        voffA[i] = (unsigned)R * lda + (unsigned)C * 2u; voffB[i] = (unsigned)Rb * ldb + (unsigned)C * 2u; rowA[i] = R; colA[i] = (unsigned)C * 2u; }
    const size_t kstep = (size_t)(BK * 2);
    const size_t hstepA = (size_t)HALF * lda, hstepB = (size_t)HALF * ldb;
    const unsigned ldsw = (unsigned)wid * 1024u;
    const int aoff = lds_byte(wr * 64 + fr, fq * 8), boff = lds_byte(wc * 32 + fr, fq * 8);
    unsigned gofc[2][2], gofn[2][2]; int gtok[2][2] = {{0, 0}, {0, 0}};
#define PG8_SA(b, h) (((b) * 2 + (h)) * HTB)
#define PG8_SB(b, h) ((4 + (b) * 2 + (h)) * HTB)
#define PG8_STAGE_B(bufoff, kbase, h) do { _Pragma("unroll") for (int _i = 0; _i < 2; ++_i) \
        __builtin_amdgcn_global_load_lds((const unsigned*)((const char*)(kbase) + (h) * hstepB + voffB[_i]), (PG8_LAS unsigned*)(lds + (bufoff) + ldsw + _i * 8192), 16, 0, 0); } while (0)
#define PG8_STAGE_A(bufoff, kbase, h, NX) do { _Pragma("unroll") for (int _i = 0; _i < 2; ++_i) { \
        const char* _p; if constexpr (GATHER) _p = (const char*)(kbase) + ((NX) ? gofn[h][_i] : gofc[h][_i]); else _p = (const char*)(kbase) + (h) * hstepA + voffA[_i]; \
        __builtin_amdgcn_global_load_lds((const unsigned*)_p, (PG8_LAS unsigned*)(lds + (bufoff) + ldsw + _i * 8192), 16, 0, 0); } } while (0)
#define PG8_LDA(dst, b, h) do { _Pragma("unroll") for (int m = 0; m < 4; ++m) { const bf16x8 _x = *(const PG8_LAS bf16x8*)(lds + PG8_SA(b, h) + aoff + m * 2048), _y = *(const PG8_LAS bf16x8*)(lds + PG8_SA(b, h) + aoff + m * 2048 + 1024); \
        if constexpr (FP8) dst##8[m] = cat8(_x, _y); else { dst[m][0] = _x; dst[m][1] = _y; } } } while (0)
#define PG8_LDB(dst, b, h) do { _Pragma("unroll") for (int n = 0; n < 2; ++n) { const bf16x8 _x = *(const PG8_LAS bf16x8*)(lds + PG8_SB(b, h) + boff + n * 2048), _y = *(const PG8_LAS bf16x8*)(lds + PG8_SB(b, h) + boff + n * 2048 + 1024); \
        if constexpr (FP8) dst##8[n] = cat8(_x, _y); else { dst[n][0] = _x; dst[n][1] = _y; } } } while (0)
#define PG8_MMA(ai, bj, At, Bt) do { __builtin_amdgcn_s_setprio(1); _Pragma("unroll") for (int m = 0; m < 4; ++m) _Pragma("unroll") for (int n = 0; n < 2; ++n) { \
        if constexpr (FP8) asm volatile("v_mfma_f32_16x16x128_f8f6f4 %0, %1, %2, %0" : "+v"(acc[ai][bj][m][n]) : "v"(Bt##8[n]), "v"(At##8[m]));     \
        else { _Pragma("unroll") for (int k = 0; k < 2; ++k) acc[ai][bj][m][n] = __builtin_amdgcn_mfma_f32_16x16x32_bf16(Bt[n][k], At[m][k], acc[ai][bj][m][n], 0, 0, 0); } } __builtin_amdgcn_s_setprio(0); } while (0)
#define PG8_WAIT_V(n) asm volatile("s_waitcnt vmcnt(" #n ")" ::: "memory")
#define PG8_WAIT_L(n) asm volatile("s_waitcnt lgkmcnt(" #n ")" ::: "memory")
#define PG8_BAR __builtin_amdgcn_s_barrier()
#define PG8_SCHED __builtin_amdgcn_sched_barrier(0)
    Unit cur, nxt; int ui = 0;
    if (!S.next(0, cur)) return;
    if constexpr (GATHER) {
#pragma unroll
        for (int h = 0; h < 2; ++h)
#pragma unroll
            for (int i = 0; i < 2; ++i) { gofc[h][i] = (unsigned)cur.tok[rowA[i] + HALF * h] * lda + colA[i]; gofn[h][i] = gofc[h][i]; }
    }
    f32x4 acc[2][2][4][2];
#pragma unroll
    for (int a = 0; a < 2; ++a)
#pragma unroll
        for (int b = 0; b < 2; ++b)
#pragma unroll
            for (int m = 0; m < 4; ++m)
#pragma unroll
                for (int n = 0; n < 2; ++n) acc[a][b][m][n] = (f32x4){0.f, 0.f, 0.f, 0.f};
    bf16x8 At[4][2], B0[2][2], B1[2][2]; i32x8 At8[4], B08[2], B18[2];
    const char* cA = cur.A; const char* cB = cur.B;
    PG8_STAGE_B(PG8_SB(0, 0), cB, 0); PG8_STAGE_B(PG8_SB(0, 1), cB, 1); PG8_STAGE_A(PG8_SA(0, 0), cA, 0, false); PG8_STAGE_A(PG8_SA(0, 1), cA, 1, false);
    if (wr == 1) PG8_BAR;
    PG8_WAIT_V(2); PG8_BAR;
    PG8_STAGE_B(PG8_SB(1, 0), cB + kstep, 0); PG8_STAGE_A(PG8_SA(1, 0), cA + kstep, 0, false); PG8_STAGE_B(PG8_SB(1, 1), cB + kstep, 1);
    PG8_WAIT_V(6); PG8_BAR;
    for (;;) {
        const bool has_next = S.next(ui + 1, nxt);
        const char* nA = has_next ? nxt.A : cA; const char* nB = has_next ? nxt.B : cB;
        for (int t = 0; t < nt; t += 2) {
            const bool last = (t == nt - 2);
            const char* a1 = cA + (size_t)(t + 1) * kstep;
            const char* a2 = last ? nA : cA + (size_t)(t + 2) * kstep; const char* b2 = last ? nB : cB + (size_t)(t + 2) * kstep;
            const char* a3 = a2 + kstep; const char* b3 = b2 + kstep;
            if constexpr (GATHER) {
                if (t == 0 && has_next) {
#pragma unroll
                    for (int h = 0; h < 2; ++h)
#pragma unroll
                        for (int i = 0; i < 2; ++i) gtok[h][i] = nxt.tok[rowA[i] + HALF * h]; }
                if (last && has_next) {
#pragma unroll
                    for (int h = 0; h < 2; ++h)
#pragma unroll
                        for (int i = 0; i < 2; ++i) gofn[h][i] = (unsigned)gtok[h][i] * lda + colA[i]; } }
            PG8_LDB(B0, 0, 0); PG8_LDB(B1, 0, 1); PG8_SCHED; PG8_LDA(At, 0, 0); PG8_STAGE_A(PG8_SA(1, 1), a1, 1, false);
            PG8_WAIT_V(8); PG8_WAIT_L(0); PG8_BAR; PG8_MMA(0, 0, At, B0); PG8_MMA(0, 1, At, B1); PG8_BAR; PG8_SCHED;
            PG8_LDA(At, 0, 1); PG8_STAGE_B(PG8_SB(0, 0), b2, 0); PG8_STAGE_B(PG8_SB(0, 1), b2, 1); PG8_STAGE_A(PG8_SA(0, 0), a2, 0, last);
            PG8_WAIT_V(8); PG8_WAIT_L(0); PG8_BAR; PG8_MMA(1, 0, At, B0); PG8_MMA(1, 1, At, B1); PG8_BAR; PG8_SCHED;
            PG8_LDB(B0, 1, 0); PG8_LDB(B1, 1, 1); PG8_SCHED; PG8_LDA(At, 1, 0); PG8_STAGE_A(PG8_SA(0, 1), a2, 1, last);
            PG8_WAIT_V(8); PG8_WAIT_L(0); PG8_BAR; PG8_MMA(0, 0, At, B0); PG8_MMA(0, 1, At, B1); PG8_BAR; PG8_SCHED;
            PG8_LDA(At, 1, 1); PG8_STAGE_B(PG8_SB(1, 0), b3, 0); PG8_STAGE_B(PG8_SB(1, 1), b3, 1); PG8_STAGE_A(PG8_SA(1, 0), a3, 0, last);
            PG8_WAIT_V(8); PG8_WAIT_L(0); PG8_BAR; PG8_MMA(1, 0, At, B0); PG8_MMA(1, 1, At, B1); PG8_BAR; PG8_SCHED;
        }
        if constexpr (ALIGN_EPI) { if (wr == 0) PG8_BAR; }
        if constexpr (FP8) {
            asm volatile("s_nop 15\n\ts_nop 7" : "+v"(acc[0][0][0][0]), "+v"(acc[0][0][0][1]), "+v"(acc[0][0][1][0]), "+v"(acc[0][0][1][1]), "+v"(acc[0][0][2][0]), "+v"(acc[0][0][2][1]), "+v"(acc[0][0][3][0]), "+v"(acc[0][0][3][1]),
                         "+v"(acc[0][1][0][0]), "+v"(acc[0][1][0][1]), "+v"(acc[0][1][1][0]), "+v"(acc[0][1][1][1]), "+v"(acc[0][1][2][0]), "+v"(acc[0][1][2][1]), "+v"(acc[0][1][3][0]), "+v"(acc[0][1][3][1]));
            asm volatile("" : "+v"(acc[1][0][0][0]), "+v"(acc[1][0][0][1]), "+v"(acc[1][0][1][0]), "+v"(acc[1][0][1][1]), "+v"(acc[1][0][2][0]), "+v"(acc[1][0][2][1]), "+v"(acc[1][0][3][0]), "+v"(acc[1][0][3][1]),
                         "+v"(acc[1][1][0][0]), "+v"(acc[1][1][0][1]), "+v"(acc[1][1][1][0]), "+v"(acc[1][1][1][1]), "+v"(acc[1][1][2][0]), "+v"(acc[1][1][2][1]), "+v"(acc[1][1][3][0]), "+v"(acc[1][1][3][1])); }
        E(acc, cur, wr, wc, fr, fq);
        if (!has_next) break;
#pragma unroll
        for (int a = 0; a < 2; ++a)
#pragma unroll
            for (int b = 0; b < 2; ++b)
#pragma unroll
                for (int m = 0; m < 4; ++m)
#pragma unroll
                    for (int n = 0; n < 2; ++n) acc[a][b][m][n] = (f32x4){0.f, 0.f, 0.f, 0.f};
        cur = nxt; cA = nA; cB = nB; ++ui;
        if constexpr (GATHER) {
#pragma unroll
            for (int h = 0; h < 2; ++h)
#pragma unroll
                for (int i = 0; i < 2; ++i) gofc[h][i] = gofn[h][i];
        }
        if constexpr (ALIGN_EPI) { if (wr == 1) PG8_BAR; }
    }
    PG8_WAIT_V(0);
    if constexpr (!ALIGN_EPI) { if (wr == 0) PG8_BAR; }
    PG8_BAR;
#undef PG8_SA
#undef PG8_SB
#undef PG8_STAGE_A
#undef PG8_STAGE_B
#undef PG8_LDA
#undef PG8_LDB
#undef PG8_MMA
#undef PG8_WAIT_V
#undef PG8_WAIT_L
#undef PG8_BAR
#undef PG8_SCHED
}
}

constexpr size_t MiB = 1u << 20;
constexpr size_t WS_CTL = 0, CTL_ZERO_BYTES = 64 * 1024;
constexpr size_t WS_SELE = 1 * MiB;
constexpr size_t WS_SELW = WS_SELE + 64 * 1024;
constexpr size_t WS_CNTG = WS_SELW + 128 * 1024;
constexpr size_t WS_ROWTOK = WS_CNTG + 8 * 1024;
constexpr size_t WS_ROWW = WS_ROWTOK + 160 * 1024;
constexpr size_t WS_TOKPOS = WS_ROWW + 160 * 1024;
constexpr size_t WS_AT = WS_TOKPOS + 128 * 1024;
static_assert(WS_AT + 32 * 1024 <= 4 * MiB, "tables");
constexpr size_t WS_WMGU = 4 * MiB;
constexpr size_t WS_WMD = 60 * MiB;
constexpr size_t WS_HN = 88 * MiB;
constexpr size_t WS_ACT = 120 * MiB;
constexpr size_t WS_BB = WS_ACT;
constexpr size_t WS_UC = WS_ACT + 32 * MiB;
constexpr size_t WS_UB = WS_ACT + 64 * MiB;
constexpr size_t WS_GC = WS_ACT + 84 * MiB;
constexpr size_t WS_GS = WS_ACT + 116 * MiB;
constexpr size_t WS_HID = WS_ACT;
constexpr size_t WS_MOEO = 240 * MiB;
constexpr size_t WS_WDGU = 268 * MiB;
constexpr size_t WS_WDD = 282 * MiB;
constexpr size_t WS_BTY = 289 * MiB;
constexpr size_t WS_BTS = 329 * MiB;
constexpr size_t WS_WIN = 338 * MiB;
constexpr size_t WS_WCO = 360 * MiB, WS_WGLU = 364 * MiB, WS_WO = 368 * MiB;
constexpr size_t WS_XB = 372 * MiB;
constexpr size_t WS_SSQ = 404 * MiB;
constexpr size_t WS_END = 405 * MiB;
static_assert(WS_HID + (size_t)MOE_ROWS * DFF <= WS_MOEO && WS_MOEO + (size_t)MOE_ROWS * D * 2 <= WS_END && WS_GS + 32 * MiB <= WS_WDGU, "map: the MoE buffers overlay the mixer activations and non-MoE weight copies (all dead by then)");
constexpr int CW_BAR = 1024;

constexpr int RING_BYTES = 131072, TAB_OFF = RING_BYTES;
constexpr int T_MISC = TAB_OFF;
constexpr int T_SELE = TAB_OFF + 128;
constexpr int T_SELW = T_SELE + 256;
constexpr int T_PEXP = T_SELW + 512;
constexpr int T_TOT = T_PEXP + 4 * (MOE_PANELS + 8);
constexpr int T_BIAS = 133120;
constexpr int T_RSTD = T_BIAS + 4 * PW;
constexpr int T_RMAP = T_RSTD + 4096;
constexpr int LDS_BYTES = 163840;
static_assert(T_TOT + 128 <= T_BIAS && T_RMAP + 16 <= LDS_BYTES, "LDS map");

#define GAS __attribute__((address_space(1)))
#define LAS __attribute__((address_space(3)))
typedef unsigned short bf16;
typedef unsigned v4u __attribute__((ext_vector_type(4)));
typedef unsigned v2u __attribute__((ext_vector_type(2)));
typedef float f32x4 __attribute__((ext_vector_type(4)));
typedef float f32x2 __attribute__((ext_vector_type(2)));
#define LDS_WAIT() asm volatile("s_waitcnt lgkmcnt(0)" ::: "memory")
using pg8::cvt_pk_bf16; using pg8::bf_lo; using pg8::bf_hi; using pg8::sigmoid_f; using pg8::gelu_tanh_f; using pg8::sig4;

#define XB_TMO      128
#define XB_XCNT(j)  (256  + 64 * (j))
#define XB_XSUB(j)  (1280 + 64 * (j))
#define XB_XGEN(j)  (2304 + 64 * (j))
#define XB_TOP      3328
#define XB_TOPGEN   3392
#define XCD_BAR_WORDS 3456
#define XB_SPIN_CAP (1u << 18)
__device__ __forceinline__ unsigned xb_ld(unsigned* p)              { return __hip_atomic_load(p, __ATOMIC_RELAXED, __HIP_MEMORY_SCOPE_AGENT); }
__device__ __forceinline__ unsigned xb_add(unsigned* p, unsigned v) { return __hip_atomic_fetch_add(p, v, __ATOMIC_RELAXED, __HIP_MEMORY_SCOPE_AGENT); }
__device__ __forceinline__ unsigned xb_xcc_id() { return (unsigned)__builtin_amdgcn_s_getreg((3 << 11) | 20) & 0xFu; }
#define XB_SPIN(cond, bar) do { unsigned _sp = 0; while (cond) { __builtin_amdgcn_s_sleep(1); \
    if ((++_sp & 255u) == 0u) { if (xb_ld(&(bar)[XB_TMO])) break; if (_sp > XB_SPIN_CAP) { atomicAdd(&(bar)[XB_TMO], 1u); break; } } } } while (0)
struct XcdBarrier { unsigned* bar; unsigned x; volatile LAS unsigned* st; };
__device__ __forceinline__ XcdBarrier xcd_barrier_post(unsigned* bar, volatile LAS unsigned* st) {
    XcdBarrier b; b.bar = bar; b.x = xb_xcc_id(); b.st = st;
    if (threadIdx.x == 0) (void)xb_add(&bar[XB_XCNT(b.x)], 1u);
    return b;
}
__device__ __forceinline__ void xcd_barrier_complete(unsigned* bar, unsigned x, unsigned& nloc, unsigned& nx) {
    const unsigned G = gridDim.x * gridDim.y * gridDim.z;
    unsigned sum, cnt, mine, sp = 0u;
    for (;;) {
        sum = 0u; cnt = 0u; mine = 0u;
#pragma unroll
        for (unsigned j = 0; j < 16; ++j) { const unsigned c = xb_ld(&bar[XB_XCNT(j)]); sum += c; cnt += (c > 0u) ? 1u : 0u; mine = (j == x) ? c : mine; }
        if (sum == G) break;
        __builtin_amdgcn_s_sleep(1);
        if ((++sp & 255u) == 0u) { if (xb_ld(&bar[XB_TMO])) break; if (sp > XB_SPIN_CAP) { atomicAdd(&bar[XB_TMO], 1u); break; } }
    }
    nloc = mine > 0u ? mine : 1u; nx = cnt > 0u ? cnt : 1u;
}
__device__ __forceinline__ void xcd_barrier(const XcdBarrier& b) {
    asm volatile("s_waitcnt vmcnt(0)" ::: "memory");
    __syncthreads();
    if (threadIdx.x == 0) {
        unsigned* bar = b.bar;
        __builtin_amdgcn_s_waitcnt(0);
        unsigned nloc = b.st[0], nx = b.st[1];
        if (nloc == 0u) { xcd_barrier_complete(bar, b.x, nloc, nx); b.st[0] = nloc; b.st[1] = nx; }
        const unsigned old = xb_add(&bar[XB_XSUB(b.x)], 1u);
        const unsigned gen = old / nloc;
        if (old + 1u == (gen + 1u) * nloc) {
            __builtin_amdgcn_fence(__ATOMIC_RELEASE, "agent");
            asm volatile("s_waitcnt vmcnt(0)" ::: "memory");
            const unsigned og = xb_add(&bar[XB_TOP], 1u);
            const unsigned tg = og / nx;
            if (og + 1u == (tg + 1u) * nx) xb_add(&bar[XB_TOPGEN], 1u);
            else XB_SPIN(xb_ld(&bar[XB_TOPGEN]) == tg, bar);
            __builtin_amdgcn_fence(__ATOMIC_ACQUIRE, "agent");
            xb_add(&bar[XB_XGEN(b.x)], 1u);
            asm volatile("s_waitcnt vmcnt(0)" ::: "memory");
        } else {
            XB_SPIN(xb_ld(&bar[XB_XGEN(b.x)]) == gen, bar);
            __builtin_amdgcn_fence(__ATOMIC_ACQUIRE, "agent");
            asm volatile("s_waitcnt vmcnt(0)" ::: "memory");
        }
    }
    __syncthreads();
}

struct Frame {
    LAS unsigned char* lds;
    int tid, lane, wave, bid, vcu, G;
    unsigned char* ws;
};
typedef const void* kcvp_t;
__device__ __forceinline__ const void* karg_ptr(int off) { const __attribute__((address_space(4))) char* b = (const __attribute__((address_space(4))) char*)__builtin_amdgcn_kernarg_segment_ptr(); asm volatile("" : "+s"(b)); return *(const __attribute__((address_space(4))) kcvp_t*)(b + off); }
#define KIN(i) ((const float*)karg_ptr(8 * (i)))
#define KOUT ((float*)karg_ptr(208))
#define KWS ((unsigned char*)karg_ptr(216))
#define MKFRAME(F) Frame F; { int t_ = threadIdx.x; asm volatile("" : "+v"(t_)); F.lds = (LAS unsigned char*)lds_raw; F.tid = t_; F.lane = t_ & 63; F.wave = __builtin_amdgcn_readfirstlane(t_ >> 6); \
    { int g_ = gridDim.x, b_ = blockIdx.x; asm volatile("" : "+s"(g_), "+s"(b_)); F.G = g_; F.bid = b_; } F.vcu = (F.G % 8 == 0) ? (F.bid % 8) * (F.G / 8) + F.bid / 8 : F.bid; F.ws = KWS; }

template <int CTRL> __device__ __forceinline__ float dpp_f(float v) { return __int_as_float(__builtin_amdgcn_update_dpp(0, __float_as_int(v), CTRL, 0xF, 0xF, true)); }
__device__ __forceinline__ float wave_sum(float v) {
#pragma unroll
    for (int o = 1; o < 64; o <<= 1) v += __shfl_xor(v, o);
    return v;
}

__device__ __forceinline__ void prep_rstd(Frame& F, const pg8::Order& o, const float* SSQ) {
    LAS int* map = (LAS int*)(F.lds + T_RMAP); LAS float* rl = (LAS float*)(F.lds + T_RSTD);
    int p0 = -1, p1 = -1, p2 = -1, p3 = -1, np = 0;
    for (int i = 0; ; ++i) { int pm, pn; if (!o.tile(i, pm, pn)) break;
        if (pm == p0 || pm == p1 || pm == p2 || pm == p3) continue;
        if (np == 0) p0 = pm; else if (np == 1) p1 = pm; else if (np == 2) p2 = pm; else if (np == 3) p3 = pm;
        ++np; }
    if (F.tid == 0) { map[0] = p0; map[1] = p1; map[2] = p2; map[3] = p3; }
#pragma unroll
    for (int it = 0; it < 2; ++it) { const int sl = 2 * it + (F.tid >> 8); const int ps = sl == 0 ? p0 : sl == 1 ? p1 : sl == 2 ? p2 : p3;
        if (ps >= 0) { const int t = F.tid & 255; const f32x4* p = (const f32x4*)(SSQ + (size_t)(ps * 256 + t) * 16); const f32x4 a = p[0], b = p[1], c = p[2], d = p[3];
            const float q = ((a[0] + a[1]) + (a[2] + a[3])) + ((b[0] + b[1]) + (b[2] + b[3])) + ((c[0] + c[1]) + (c[2] + c[3])) + ((d[0] + d[1]) + (d[2] + d[3]));
            rl[sl * 256 + t] = 1.0f / sqrtf(q * (1.0f / D) + RMS_EPS); } }
    __syncthreads();
}
__device__ __forceinline__ void prep_bias(Frame& F, const float* bias) {
    LAS float* bl = (LAS float*)(F.lds + T_BIAS);
    for (int i = F.tid; i < PW; i += 512) bl[i] = bias[i];
    __syncthreads();
}
struct SchedPlain {
    pg8::Order o; const char* A; const char* B; size_t tA, tB;
    __device__ __forceinline__ bool next(int i, pg8::Unit& u) const { int pm, pn; if (!o.tile(i, pm, pn)) return false; u.pm = pm; u.pn = pn; u.aux = 0; u.A = A + (size_t)pm * tA; u.B = B + (size_t)pn * tB; u.tok = nullptr; return true; }
};
struct SchedSsmY {
    pg8::Order o; const char* UB; const char* BTY;
    __device__ __forceinline__ bool next(int i, pg8::Unit& u) const { int pm, pnn; if (!o.tile(i, pm, pnn)) return false; const int g = pnn >> 1; u.pm = pm; u.pn = pnn & 1; u.aux = g;
        u.A = UB + (size_t)pm * 256 * (NG * KY * 2) + (size_t)g * (KY * 2); u.B = BTY + (size_t)pnn * 256 * (KY * 2); u.tok = nullptr; return true; }
};
struct SchedSsmS {
    pg8::Order o; const char* UB; const char* BTS;
    __device__ __forceinline__ bool next(int i, pg8::Unit& u) const { int pm, g; if (!o.tile(i, pm, g)) return false; u.pm = pm; u.pn = 0; u.aux = g;
        u.A = UB + (size_t)pm * 256 * (NG * KY * 2) + (size_t)g * (KY * 2); u.B = BTS + (size_t)g * 128 * (512 * 2); u.tok = nullptr; return true; }
};
struct SchedMoe1 {
    pg8::Order o; const char* HN; const char* W; const int* rowtok; const LAS int* pexp;
    __device__ __forceinline__ bool next(int i, pg8::Unit& u) const { int pm, pn; if (!o.tile(i, pm, pn)) return false; const int e = pexp[pm]; u.pm = pm; u.pn = pn; u.aux = e;
        u.A = HN; u.B = W + (size_t)e * (2 * DFF) * D + (size_t)pn * 256 * D; u.tok = rowtok + pm * 256; return true; }
};
struct SchedMoe2 {
    pg8::Order o; const char* HID; const char* W; const LAS int* pexp;
    __device__ __forceinline__ bool next(int i, pg8::Unit& u) const { int pm, pn; if (!o.tile(i, pm, pn)) return false; const int e = pexp[pm]; u.pm = pm; u.pn = pn; u.aux = e;
        u.A = HID + (size_t)pm * 256 * DFF; u.B = W + (size_t)e * D * DFF + (size_t)pn * 256 * DFF; u.tok = nullptr; return true; }
};

struct SchedMoe2L {
    int nunits, c; const char* HID; const char* W; const LAS int* pexp;
    __device__ __forceinline__ bool next(int i, pg8::Unit& u) const { if (i > 0 || c >= nunits) return false; const int pm = 128 + (c >> 3), pn = (c >> 1) & 3, kh = c & 1, e = pexp[pm];
        u.pm = pm; u.pn = pn; u.aux = kh; u.A = HID + (size_t)pm * 256 * DFF + (size_t)kh * (DFF / 2); u.B = W + (size_t)e * D * DFF + (size_t)pn * 256 * DFF + (size_t)kh * (DFF / 2); u.tok = nullptr; return true; }
};
using pg8::Unit; using pg8::HALF; using pg8::BM;
typedef const f32x4 (&AccRef)[2][2][4][2];
constexpr int HN_SH = 4, WGU_SH = 7, HID_SH = 3, WD_SH = 8;
__device__ __forceinline__ float clamp8(float v) { return __builtin_fminf(__builtin_fmaxf(v, -440.0f), 440.0f); }
__device__ __forceinline__ unsigned pk4_fp8(float a, float b, float c, float d) { unsigned w = 0u; w = (unsigned)__builtin_amdgcn_cvt_pk_fp8_f32(a, b, (int)w, false); w = (unsigned)__builtin_amdgcn_cvt_pk_fp8_f32(c, d, (int)w, true); return w; }
__device__ __forceinline__ v4u pack8(const f32x4 a, const f32x4 b) { v4u w; w.x = cvt_pk_bf16(a[0], a[1]); w.y = cvt_pk_bf16(a[2], a[3]); w.z = cvt_pk_bf16(b[0], b[1]); w.w = cvt_pk_bf16(b[2], b[3]); return w; }
__device__ __forceinline__ void unpack8(const v4u w, f32x4& a, f32x4& b) { a = (f32x4){bf_lo(w.x), bf_hi(w.x), bf_lo(w.y), bf_hi(w.y)}; b = (f32x4){bf_lo(w.z), bf_hi(w.z), bf_lo(w.w), bf_hi(w.w)}; }

__device__ __forceinline__ void row_rstd(const float* SSQ, const LAS unsigned char* lds, int pm, int rloc, float (&rs)[2][4]) {
    const LAS int* map = (const LAS int*)(lds + T_RMAP); const LAS float* rl = (const LAS float*)(lds + T_RSTD);
    const int sl = map[0] == pm ? 0 : map[1] == pm ? 1 : map[2] == pm ? 2 : map[3] == pm ? 3 : -1;
    if (sl >= 0) {
#pragma unroll
        for (int ai = 0; ai < 2; ++ai)
#pragma unroll
            for (int m = 0; m < 4; ++m) rs[ai][m] = rl[sl * 256 + rloc + ai * HALF + m * 16];
    } else {
#pragma unroll
        for (int ai = 0; ai < 2; ++ai)
#pragma unroll
            for (int m = 0; m < 4; ++m) { const f32x4* p = (const f32x4*)(SSQ + (size_t)(pm * BM + rloc + ai * HALF + m * 16) * 16); const f32x4 a = p[0], b = p[1], c = p[2], d = p[3];
                const float t = ((a[0] + a[1]) + (a[2] + a[3])) + ((b[0] + b[1]) + (b[2] + b[3])) + ((c[0] + c[1]) + (c[2] + c[3])) + ((d[0] + d[1]) + (d[2] + d[3]));
                rs[ai][m] = 1.0f / sqrtf(t * (1.0f / D) + RMS_EPS); }
    }
}
struct EpiProj {
    static constexpr bool PERM = true;
    bf16* BB; bf16* UC; bf16* UB; bf16* GC; bf16* GS; const LAS unsigned char* lds; const float* SSQ;
    __device__ __forceinline__ void operator()(AccRef acc, const Unit& u, int wr, int wc, int fr, int fq) const {
        const int row0 = u.pm * BM + wr * 64 + fr, cl = wc * 32 + 8 * fq, pn = u.pn;
        float rs[2][4]; row_rstd(SSQ, lds, u.pm, wr * 64 + fr, rs); const LAS float* bias = (const LAS float*)(lds + T_BIAS);
        if (pn >= 4 && pn < 12) {
            const int q = pn - 4, ch = 128 * q + cl;
            const f32x4 bc0 = *(const LAS f32x4*)(bias + 1024 + ch), bc1 = *(const LAS f32x4*)(bias + 1024 + ch + 4), bv0 = *(const LAS f32x4*)(bias + 2048 + ch), bv1 = *(const LAS f32x4*)(bias + 2048 + ch + 4);
#pragma unroll
            for (int ai = 0; ai < 2; ++ai)
#pragma unroll
                for (int m = 0; m < 4; ++m) { const int row = row0 + ai * HALF + m * 16;
                    const float r = rs[ai][m]; const f32x4 p0 = (acc[ai][0][m][0] * r + bc0) * (acc[ai][1][m][0] * r + bv0), p1 = (acc[ai][0][m][1] * r + bc1) * (acc[ai][1][m][1] * r + bv1);
                    *(v4u*)(UC + (size_t)row * D + ch) = pack8(p0, p1); }
            return;
        }
#pragma unroll
        for (int bj = 0; bj < 2; ++bj) {
            const int dcol = pn * BM + bj * HALF + cl;
            const f32x4 b0 = *(const LAS f32x4*)(bias + dcol), b1 = *(const LAS f32x4*)(bias + dcol + 4);
#pragma unroll
            for (int ai = 0; ai < 2; ++ai)
#pragma unroll
                for (int m = 0; m < 4; ++m) { const int row = row0 + ai * HALF + m * 16;
                    f32x4 v0 = acc[ai][bj][m][0] * rs[ai][m] + b0, v1 = acc[ai][bj][m][1] * rs[ai][m] + b1;
                    if (pn < 4) { *(v4u*)(BB + (size_t)row * D + dcol) = pack8(v0, v1); }
                    else if (pn < 14) { const int cu = dcol - 3072, g = cu >> 4, cp = cu & 15;
                        *(v4u*)(UB + ((size_t)(row >> 5) * NG + g) * KY + (row & 31) * 16 + cp) = pack8(v0, v1); }
                    else {
                        v0 = sig4(v0); v1 = sig4(v1);
                        if (pn < 18) *(v4u*)(GC + (size_t)row * D + (dcol - 3584)) = pack8(v0, v1);
                        else *(v4u*)(GS + (size_t)row * D + (dcol - 4608)) = pack8(v0, v1); } }
        }
    }
};
struct EpiSloc {
    static constexpr bool PERM = false;
    float* SL;
    __device__ __forceinline__ void operator()(AccRef acc, const Unit& u, int wr, int wc, int fr, int fq) const {
        const int row0 = u.pm * BM + wr * 64 + fr, col0 = wc * 32 + 4 * fq;
#pragma unroll
        for (int ai = 0; ai < 2; ++ai)
#pragma unroll
            for (int m = 0; m < 4; ++m) { float* p = SL + ((size_t)(row0 + ai * HALF + m * 16) * NG + u.aux) * 128 + col0;
#pragma unroll
                for (int n = 0; n < 2; ++n) *(f32x4*)(p + n * 16) = acc[ai][0][m][n]; }
    }
};
struct EpiY {
    static constexpr bool PERM = true;
    bf16* YB; const bf16* UB; const float* dsk;
    __device__ __forceinline__ void operator()(AccRef acc, const Unit& u, int wr, int wc, int fr, int fq) const {
        const int row0 = u.pm * BM + wr * 64 + fr, g = u.aux;
#pragma unroll
        for (int bj = 0; bj < 2; ++bj) {
            const int col = u.pn * BM + bj * HALF + wc * 32 + 8 * fq, j = col >> 4, c = col & 15, ch = g * 16 + c;
            const f32x4 d0 = *(const f32x4*)(dsk + ch), d1 = *(const f32x4*)(dsk + ch + 4);
#pragma unroll
            for (int ai = 0; ai < 2; ++ai)
#pragma unroll
                for (int m = 0; m < 4; ++m) { const int chunk = row0 + ai * HALF + m * 16;
                    const v4u uw = *(const v4u*)(UB + ((size_t)chunk * NG + g) * KY + j * 16 + c); f32x4 u0, u1; unpack8(uw, u0, u1);
                    f32x4 v0 = acc[ai][bj][m][0] + d0 * u0, v1 = acc[ai][bj][m][1] + d1 * u1;
#pragma unroll
                    for (int k = 0; k < 4; ++k) { v0[k] = gelu_tanh_f(v0[k]); v1[k] = gelu_tanh_f(v1[k]); }
                    *(v4u*)(YB + ((size_t)chunk * TCH + j) * DSSM + ch) = pack8(v0, v1); }
        }
    }
};
struct EpiConvOut {
    static constexpr bool PERM = true;
    bf16* GC;
    __device__ __forceinline__ void operator()(AccRef acc, const Unit& u, int wr, int wc, int fr, int fq) const {
        const int row0 = u.pm * BM + wr * 64 + fr;
#pragma unroll
        for (int ai = 0; ai < 2; ++ai)
#pragma unroll
            for (int m = 0; m < 4; ++m)
#pragma unroll
                for (int bj = 0; bj < 2; ++bj) { bf16* p = GC + (size_t)(row0 + ai * HALF + m * 16) * D + u.pn * BM + bj * HALF + wc * 32 + 8 * fq;
                    f32x4 g0, g1; unpack8(*(const v4u*)p, g0, g1); *(v4u*)p = pack8(g0 * acc[ai][bj][m][0], g1 * acc[ai][bj][m][1]); }
    }
};
struct EpiGlu {
    static constexpr bool PERM = true;
    bf16* P1; const bf16* GS;
    __device__ __forceinline__ void operator()(AccRef acc, const Unit& u, int wr, int wc, int fr, int fq) const {
        const int row0 = u.pm * BM + wr * 64 + fr, ch = u.pn * HALF + wc * 32 + 8 * fq;
#pragma unroll
        for (int ai = 0; ai < 2; ++ai)
#pragma unroll
            for (int m = 0; m < 4; ++m) { const size_t off = (size_t)(row0 + ai * HALF + m * 16) * D + ch;
                f32x4 p0, p1, s0, s1; unpack8(*(const v4u*)(P1 + off), p0, p1); unpack8(*(const v4u*)(GS + off), s0, s1);
                f32x4 z0 = acc[ai][0][m][0], z1 = acc[ai][0][m][1]; const f32x4 y0 = acc[ai][1][m][0], y1 = acc[ai][1][m][1];
                z0 = p0 + s0 * z0 * sig4(y0); z1 = p1 + s1 * z1 * sig4(y1);
                *(v4u*)(P1 + off) = pack8(z0, z1); }
    }
};
struct EpiRes {
    static constexpr bool PERM = true;
    bf16* XB; float* SSQ;
    __device__ __forceinline__ void operator()(AccRef acc, const Unit& u, int wr, int wc, int fr, int fq) const {
        const int row0 = u.pm * BM + wr * 64 + fr, col0 = u.pn * BM + wc * 32 + 8 * fq;
#pragma unroll
        for (int ai = 0; ai < 2; ++ai)
#pragma unroll
            for (int m = 0; m < 4; ++m) { const int row = row0 + ai * HALF + m * 16; float s = 0.f;
#pragma unroll
                for (int bj = 0; bj < 2; ++bj) { bf16* p = XB + (size_t)row * D + col0 + bj * HALF; f32x4 x0, x1; unpack8(*(const v4u*)p, x0, x1);
                    x0 += acc[ai][bj][m][0]; x1 += acc[ai][bj][m][1]; *(v4u*)p = pack8(x0, x1);
                    s += ((x0[0] * x0[0] + x0[1] * x0[1]) + (x0[2] * x0[2] + x0[3] * x0[3])) + ((x1[0] * x1[0] + x1[1] * x1[1]) + (x1[2] * x1[2] + x1[3] * x1[3])); }
                s += __shfl_xor(s, 16); s += __shfl_xor(s, 32);
                if (fq == 0) SSQ[(size_t)row * 16 + u.pn * 4 + wc] = s; }
    }
};
struct EpiSwiglu {
    static constexpr bool PERM = true;
    bf16* H; const float* SSQ; const LAS unsigned char* lds;
    __device__ __forceinline__ void operator()(AccRef acc, const Unit& u, int wr, int wc, int fr, int fq) const {
        const int row0 = u.pm * BM + wr * 64 + fr, ch = u.pn * HALF + wc * 32 + 8 * fq;
        float rs[2][4]; row_rstd(SSQ, lds, u.pm, wr * 64 + fr, rs);
#pragma unroll
        for (int ai = 0; ai < 2; ++ai)
#pragma unroll
            for (int m = 0; m < 4; ++m) { const float r = rs[ai][m], r2 = r * r; f32x4 g0 = acc[ai][0][m][0], g1 = acc[ai][0][m][1]; const f32x4 u0 = acc[ai][1][m][0], u1 = acc[ai][1][m][1];
                g0 = (g0 * u0) * (sig4(g0 * r) * r2); g1 = (g1 * u1) * (sig4(g1 * r) * r2);
                *(v4u*)(H + (size_t)(row0 + ai * HALF + m * 16) * DFF + ch) = pack8(g0, g1); }
    }
};
struct EpiSwiglu8 {
    static constexpr bool PERM = true;
    unsigned char* H;
    __device__ __forceinline__ void operator()(AccRef acc, const Unit& u, int wr, int wc, int fr, int fq) const {
        const int row0 = u.pm * BM + wr * 64 + fr, ch = u.pn * HALF + wc * 32 + 8 * fq; const float sc = (float)(1 << HID_SH) / (float)(1 << (HN_SH + WGU_SH)), si = 1.0f / (float)(1 << (HN_SH + WGU_SH));
#pragma unroll
        for (int ai = 0; ai < 2; ++ai)
#pragma unroll
            for (int m = 0; m < 4; ++m) { f32x4 g0 = acc[ai][0][m][0], g1 = acc[ai][0][m][1]; const f32x4 u0 = acc[ai][1][m][0], u1 = acc[ai][1][m][1];
                g0 = (g0 * u0) * (sig4(g0 * si) * (sc * si)); g1 = (g1 * u1) * (sig4(g1 * si) * (sc * si));
#pragma unroll
                for (int k = 0; k < 4; ++k) { g0[k] = clamp8(g0[k]); g1[k] = clamp8(g1[k]); }
                v2u w; w.x = pk4_fp8(g0[0], g0[1], g0[2], g0[3]); w.y = pk4_fp8(g1[0], g1[1], g1[2], g1[3]);
                *(v2u*)(H + (size_t)(row0 + ai * HALF + m * 16) * DFF + ch) = w; }
    }
};
struct EpiMoeDown {
    static constexpr bool PERM = true;
    bf16* O; const float* roww;
    __device__ __forceinline__ void operator()(AccRef acc, const Unit& u, int wr, int wc, int fr, int fq) const {
        const int row0 = u.pm * BM + wr * 64 + fr;
#pragma unroll
        for (int ai = 0; ai < 2; ++ai)
#pragma unroll
            for (int m = 0; m < 4; ++m) { const int row = row0 + ai * HALF + m * 16; const float w = roww[row] * (1.0f / (float)(1 << (HID_SH + WD_SH)));
#pragma unroll
                for (int bj = 0; bj < 2; ++bj) *(v4u*)(O + (size_t)row * D + u.pn * BM + bj * HALF + wc * 32 + 8 * fq) = pack8(acc[ai][bj][m][0] * w, acc[ai][bj][m][1] * w); }
    }
};

struct EpiMoePart {
    static constexpr bool PERM = true;
    bf16* P; const float* roww;
    __device__ __forceinline__ void operator()(AccRef acc, const Unit& u, int wr, int wc, int fr, int fq) const {
        const int row0 = u.pm * BM + wr * 64 + fr; bf16* base = P + (size_t)u.aux * 2048 * D;
#pragma unroll
        for (int ai = 0; ai < 2; ++ai)
#pragma unroll
            for (int m = 0; m < 4; ++m) { const int row = row0 + ai * HALF + m * 16; const float w = roww[row] * (1.0f / (float)(1 << (HID_SH + WD_SH)));
#pragma unroll
                for (int bj = 0; bj < 2; ++bj) *(v4u*)(base + (size_t)(row - 32768) * D + u.pn * BM + bj * HALF + wc * 32 + 8 * fq) = pack8(acc[ai][bj][m][0] * w, acc[ai][bj][m][1] * w); }
    }
};
template <bool FP8> __device__ __forceinline__ void tr_item2(const float* W, int N, int k0, int n0, unsigned char* dst, size_t ld_bytes, int drow0, float scale, LAS unsigned* scr, int lane, const float* gk = nullptr) {
    float v[128];
    const float* src = W + (size_t)k0 * N + n0 + lane;
#pragma unroll
    for (int i = 0; i < 128; ++i) v[i] = __builtin_nontemporal_load(src + (size_t)i * N);
    if (!FP8 && gk) {
#pragma unroll
        for (int i = 0; i < 128; ++i) v[i] *= gk[k0 + i]; }
#pragma unroll
    for (int hlf = 0; hlf < (FP8 ? 1 : 2); ++hlf) {
        unsigned dw[32];
        if constexpr (FP8) {
#pragma unroll
            for (int i = 0; i < 32; ++i) dw[i] = pk4_fp8(v[4 * i] * scale, v[4 * i + 1] * scale, v[4 * i + 2] * scale, v[4 * i + 3] * scale);
        } else {
#pragma unroll
            for (int i = 0; i < 32; ++i) dw[i] = cvt_pk_bf16(v[hlf * 64 + 2 * i], v[hlf * 64 + 2 * i + 1]); }
#pragma unroll
        for (int i = 0; i < 8; ++i) *(LAS v4u*)(scr + lane * 36 + 4 * i) = (v4u){dw[4 * i], dw[4 * i + 1], dw[4 * i + 2], dw[4 * i + 3]};
        LDS_WAIT(); asm volatile("" ::: "memory");
        const int c = lane & 7; const size_t kb = FP8 ? (size_t)k0 : (size_t)(k0 + hlf * 64) * 2;
#pragma unroll
        for (int j = 0; j < 8; ++j) { const int r = (lane >> 3) + 8 * j; const v4u o = *(const LAS v4u*)(scr + r * 36 + 4 * c);
            __builtin_nontemporal_store(o, (GAS v4u*)(dst + (size_t)(drow0 + r) * ld_bytes + kb + 16 * c)); }
        LDS_WAIT(); asm volatile("" ::: "memory");
    }
}
__device__ __forceinline__ int pair_row(int ch, int second) { return (ch >> 7) * 256 + (ch & 127) + (second ? 128 : 0); }
constexpr int I_MGU = 8 * 56, I_MD = 28 * 16;
constexpr int N8 = 8 * (2 * I_MGU + I_MD);
#ifndef WIN_A
#define WIN_A 2
#define WIN_B 3
#endif
constexpr int WIN_PROJ = WIN_A, WIN_E = WIN_B;
constexpr int NDEFER = 2 * 1024 * (WIN_PROJ + WIN_E);
static_assert(NDEFER <= N8, "windows");
__device__ __forceinline__ void tr_moe_item(Frame& F, int r, LAS unsigned* scr) {
    unsigned char* ws = F.ws;
    const int e = r / (2 * I_MGU + I_MD); r %= (2 * I_MGU + I_MD);
    if (r < 2 * I_MGU) { const int sgu = r / I_MGU; r %= I_MGU; const int n0 = (r % 56) * 64;
        tr_item2<true>((sgu ? KIN(23) : KIN(22)) + (size_t)e * D * DFF, DFF, (r / 56) * 128, n0, ws + WS_WMGU + (size_t)e * 2 * DFF * D, D, pair_row(n0, sgu), (float)(1 << WGU_SH), scr, F.lane); }
    else { r -= 2 * I_MGU; tr_item2<true>(KIN(24) + (size_t)e * DFF * D, D, (r / 16) * 128, (r % 16) * 64, ws + WS_WMD + (size_t)e * D * DFF, DFF, (r % 16) * 64, (float)(1 << WD_SH), scr, F.lane); }
}
__device__ __forceinline__ void tr_window(Frame& F, int l, int kind, int rank) {
    LAS unsigned* scr = (LAS unsigned*)(F.lds + 49152 + F.wave * 9216);
    const int base = l * 1024 * (WIN_PROJ + WIN_E) + (kind ? 1024 * WIN_PROJ : 0), n = kind ? WIN_E : WIN_PROJ;
#pragma unroll 1
    for (int k = 0; k < n; ++k) tr_moe_item(F, base + k * 1024 + rank * 8 + F.wave, scr);
}
__device__ __forceinline__ void p0_transposes(Frame& F) {
    LAS unsigned* scr = (LAS unsigned*)(F.lds + 49152 + F.wave * 9216);
    const int gw = F.vcu * 8 + F.wave, NGW = F.G * 8;
    constexpr int I_IN = 8 * 88, I_SQ = 8 * 16, I_GLU = 4 * 32, I_GU = 8 * 56, I_DN = 28 * 16;
    constexpr int NIT = N8 + 2 * I_IN + 2 * I_SQ + 2 * I_GLU + 2 * I_SQ + 2 * I_GU + I_DN;
    unsigned char* ws = F.ws;
    for (int it = (F.G == 256 ? NDEFER : 0) + gw; it < NIT; it += NGW) {
        int r = it;
        if (r < N8) { tr_moe_item(F, r, scr); continue; }
        r -= N8;
        if (r < 2 * I_IN) { const int l = r / I_IN; r %= I_IN; const int n0 = (r % 88) * 64; int d = n0;
            if (n0 >= 1024 && n0 < 2048) d = 1024 + pair_row(n0 - 1024, 0); else if (n0 >= 2048 && n0 < 3072) d = 1024 + pair_row(n0 - 2048, 1);
            tr_item2<false>(KIN(2) + (size_t)l * D * PW, PW, (r / 88) * 128, n0, ws + WS_WIN + (size_t)l * PW * D * 2, D * 2, d, 1.f, scr, F.lane, KIN(1) + l * D); continue; }
        r -= 2 * I_IN;
        if (r < 2 * I_SQ) { const int l = r / I_SQ; r %= I_SQ; tr_item2<false>(KIN(5) + (size_t)l * D * D, D, (r / 16) * 128, (r % 16) * 64, ws + WS_WCO + (size_t)l * D * D * 2, D * 2, (r % 16) * 64, 1.f, scr, F.lane); continue; }
        r -= 2 * I_SQ;
        if (r < 2 * I_GLU) { const int l = r / I_GLU; r %= I_GLU; const int n0 = (r % 32) * 64; const int d = n0 < 1024 ? pair_row(n0, 0) : pair_row(n0 - 1024, 1);
            tr_item2<false>(KIN(14) + (size_t)l * DSSM * 2048, 2048, (r / 32) * 128, n0, ws + WS_WGLU + (size_t)l * 2048 * DSSM * 2, DSSM * 2, d, 1.f, scr, F.lane); continue; }
        r -= 2 * I_GLU;
        if (r < 2 * I_SQ) { const int l = r / I_SQ; r %= I_SQ; tr_item2<false>(KIN(15) + (size_t)l * D * D, D, (r / 16) * 128, (r % 16) * 64, ws + WS_WO + (size_t)l * D * D * 2, D * 2, (r % 16) * 64, 1.f, scr, F.lane); continue; }
        r -= 2 * I_SQ;
        if (r < 2 * I_GU) { const int sgu = r / I_GU; r %= I_GU; const int n0 = (r % 56) * 64;
            tr_item2<false>(sgu ? KIN(18) : KIN(17), DFF, (r / 56) * 128, n0, ws + WS_WDGU, D * 2, pair_row(n0, sgu), 1.f, scr, F.lane, KIN(16)); continue; }
        r -= 2 * I_GU;
        tr_item2<false>(KIN(19), D, (r / 16) * 128, (r % 16) * 64, ws + WS_WDD, DFF * 2, (r % 16) * 64, 1.f, scr, F.lane);
    }
}
__device__ __forceinline__ void p0_ssm_job(Frame& F, int l, int g, int cq) {
    LAS f32x2* pw = (LAS f32x2*)(F.lds);
    LAS f32x2* bbL = pw + 33 * 64;
    LAS f32x2* CL = bbL + 64 * 16;
    LAS float* KmL = (LAS float*)(CL + 16 * 64);
    const int t = F.tid, lg = l * NG + g;
    const float* a_re = KIN(6); const float* a_im = KIN(7); const float* ldt = KIN(8); const float* b_re = KIN(9); const float* b_im = KIN(10); const float* c_re = KIN(11); const float* c_im = KIN(12);
    for (int idx = t; idx < 1024; idx += 512) CL[idx] = (f32x2){c_re[(size_t)lg * 1024 + idx], c_im[(size_t)lg * 1024 + idx]};
    if (t < 64) {
        const int n = t; const float ar = a_re[lg * 64 + n], ai = a_im[lg * 64 + n], dt = expf(ldt[lg]);
        const float mag = expf(ar * dt), ang = ai * dt; float sn, cs; sn = sinf(ang); cs = cosf(ang);
        const float are = mag * cs, aim = mag * sn, den = ar * ar + ai * ai, nr = are - 1.0f, ni = aim;
        const float cre = (nr * ar + ni * ai) / den, cim = (ni * ar - nr * ai) / den;
        float pr = 1.0f, pi = 0.0f; pw[n] = (f32x2){1.0f, 0.0f};
        for (int d = 1; d <= TCH; ++d) { const float qr = pr * are - pi * aim, qi = pr * aim + pi * are; pr = qr; pi = qi; pw[d * 64 + n] = (f32x2){pr, pi}; }
        if (cq == 0) ((f32x2*)(F.ws + WS_AT))[lg * 64 + n] = (f32x2){pr, pi};
#pragma unroll
        for (int c = 0; c < 16; ++c) { const float br = b_re[((size_t)lg * 64 + n) * 16 + c], bi = b_im[((size_t)lg * 64 + n) * 16 + c]; bbL[n * 16 + c] = (f32x2){cre * br - cim * bi, cre * bi + cim * br}; }
    }
    __syncthreads();
    { const int cp = t & 15, cc = (t >> 4) & 3, dq = t >> 6;
#pragma unroll
      for (int r = 0; r < 4; ++r) { const int d = dq * 4 + r; float s = 0.f;
          for (int n = 0; n < 64; ++n) { const f32x2 C = CL[(4 * cq + cc) * 64 + n], p = pw[d * 64 + n], b = bbL[n * 16 + cp];
              const float xr = C.x * p.x - C.y * p.y, xi = C.x * p.y + C.y * p.x; s += xr * b.x - xi * b.y; }
          KmL[(d * 4 + cc) * 16 + cp] = s; } }
    __syncthreads();
    const int q = F.lane, i = q >> 1, c0 = (q & 1) * 8;
    for (int rr = F.wave; rr < 128; rr += 8) {
        const int j = rr >> 2, cc = rr & 3, c = 4 * cq + cc;
        bf16* dst = (bf16*)(F.ws + WS_BTY) + ((size_t)lg * 512 + j * 16 + c) * KY;
        float v[8];
#pragma unroll
        for (int e = 0; e < 8; ++e) v[e] = (i <= j) ? KmL[((j - i) * 4 + cc) * 16 + c0 + e] : 0.0f;
        v4u o; o.x = cvt_pk_bf16(v[0], v[1]); o.y = cvt_pk_bf16(v[2], v[3]); o.z = cvt_pk_bf16(v[4], v[5]); o.w = cvt_pk_bf16(v[6], v[7]);
        *(GAS v4u*)(dst + q * 8) = o;
        if (q < 16) { const int part = q >> 3, n0 = (q & 7) * 8;
#pragma unroll
            for (int e = 0; e < 8; ++e) { const f32x2 C = CL[c * 64 + n0 + e], p = pw[(j + 1) * 64 + n0 + e]; v[e] = part ? -(C.x * p.y + C.y * p.x) : (C.x * p.x - C.y * p.y); }
            o.x = cvt_pk_bf16(v[0], v[1]); o.y = cvt_pk_bf16(v[2], v[3]); o.z = cvt_pk_bf16(v[4], v[5]); o.w = cvt_pk_bf16(v[6], v[7]);
            *(GAS v4u*)(dst + 512 + q * 8) = o; }
    }
    for (int rr = F.wave * 4; rr < F.wave * 4 + 4; ++rr) {
        const int part = rr >> 4, n = 16 * cq + (rr & 15);
        bf16* dst = (bf16*)(F.ws + WS_BTS) + ((size_t)lg * 128 + part * 64 + n) * 512;
        const f32x2 p = pw[(TCH - 1 - i) * 64 + n]; float v[8];
#pragma unroll
        for (int e = 0; e < 8; ++e) { const f32x2 b = bbL[n * 16 + c0 + e]; v[e] = part ? (p.x * b.y + p.y * b.x) : (p.x * b.x - p.y * b.y); }
        v4u o; o.x = cvt_pk_bf16(v[0], v[1]); o.y = cvt_pk_bf16(v[2], v[3]); o.z = cvt_pk_bf16(v[4], v[5]); o.w = cvt_pk_bf16(v[6], v[7]);
        *(GAS v4u*)(dst + q * 8) = o;
    }
    __syncthreads();
}

__device__ __forceinline__ void t_xcvt(Frame& F, const float* X, bf16* XB, float* SSQ) {
    const int gw = F.vcu * 8 + F.wave, NGW = F.G * 8;
    for (int m0 = gw * 4; m0 < M; m0 += NGW * 4) {
        f32x4 v[4][4];
#pragma unroll
        for (int r = 0; r < 4; ++r) { const f32x4* xr = (const f32x4*)(X + (size_t)(m0 + r) * D) + F.lane;
#pragma unroll
            for (int j = 0; j < 4; ++j) v[r][j] = __builtin_nontemporal_load(xr + 64 * j); }
#pragma unroll
        for (int r = 0; r < 4; ++r) { float s = 0.f;
#pragma unroll
            for (int j = 0; j < 4; ++j) s += (v[r][j][0] * v[r][j][0] + v[r][j][1] * v[r][j][1]) + (v[r][j][2] * v[r][j][2] + v[r][j][3] * v[r][j][3]);
            s = wave_sum(s);
            v2u* o = (v2u*)(XB + (size_t)(m0 + r) * D) + F.lane;
#pragma unroll
            for (int j = 0; j < 4; ++j) { v2u w; w.x = cvt_pk_bf16(v[r][j][0], v[r][j][1]); w.y = cvt_pk_bf16(v[r][j][2], v[r][j][3]); o[64 * j] = w; }
            if (F.lane < 16) SSQ[(size_t)(m0 + r) * 16 + F.lane] = F.lane == 0 ? s : 0.f; }
    }
}
__device__ __forceinline__ void t_norm_router(Frame& F, const bf16* X, const float* gvec, bf16* HN, const float* rw, const float* rb) {
    f32x4 g[4]; f32x4 rwv[4][4][2];
    {
        LAS float* rl = (LAS float*)F.lds;
#pragma unroll
        for (int i = 0; i < 4; ++i) { const int q = F.tid + 512 * i, k = q >> 1, hf = q & 1; *(LAS f32x4*)(rl + (k >> 2) * 36 + (k & 3) * 8 + hf * 4) = ((const f32x4*)rw)[q]; }
        __syncthreads();
#pragma unroll
        for (int j = 0; j < 4; ++j) { g[j] = ((const f32x4*)gvec)[F.lane + 64 * j];
#pragma unroll
            for (int c = 0; c < 4; ++c) { const LAS f32x4* p = (const LAS f32x4*)(rl + (j * 64 + F.lane) * 36 + c * 8); rwv[j][c][0] = p[0]; rwv[j][c][1] = p[1]; } }
    }
    LAS int* selE = (LAS int*)(F.lds + T_SELE); LAS float* selW = (LAS float*)(F.lds + T_SELW);
    v2u xin[8][4];
#pragma unroll
    for (int k = 0; k < 8; ++k) { const v2u* xr = (const v2u*)(X + (size_t)(F.bid * 64 + F.wave * 8 + k) * D) + F.lane;
#pragma unroll
        for (int j = 0; j < 4; ++j) xin[k][j] = xr[64 * j]; }
#pragma unroll
    for (int k = 0; k < 8; ++k) {
        const int tl = F.wave * 8 + k, m = F.bid * 64 + tl;
        f32x4 v[4]; float red[9];
#pragma unroll
        for (int e = 0; e < 9; ++e) red[e] = 0.f;
#pragma unroll
        for (int j = 0; j < 4; ++j) { const v2u a = xin[k][j]; v[j] = (f32x4){bf_lo(a.x), bf_hi(a.x), bf_lo(a.y), bf_hi(a.y)}; red[8] += (v[j][0] * v[j][0] + v[j][1] * v[j][1]) + (v[j][2] * v[j][2] + v[j][3] * v[j][3]);
            v[j] = v[j] * g[j];
#pragma unroll
            for (int c = 0; c < 4; ++c)
#pragma unroll
                for (int e = 0; e < 8; ++e) red[e] += v[j][c] * rwv[j][c][e >> 2][e & 3]; }
#pragma unroll
        for (int e = 0; e < 9; ++e) {
            red[e] += dpp_f<0xB1>(red[e]); red[e] += dpp_f<0x4E>(red[e]); red[e] += dpp_f<0x141>(red[e]); red[e] += dpp_f<0x140>(red[e]); }
#pragma unroll
        for (int o = 16; o < 64; o <<= 1) { float t[9];
#pragma unroll
            for (int e = 0; e < 9; ++e) t[e] = __shfl_xor(red[e], o);
#pragma unroll
            for (int e = 0; e < 9; ++e) red[e] += t[e]; }
        const float rstd = 1.0f / sqrtf(red[8] * (1.0f / D) + RMS_EPS);
        unsigned* o = (unsigned*)((unsigned char*)HN + (size_t)m * D) + F.lane; const float hsc = (float)(1 << HN_SH) * rstd;
#pragma unroll
        for (int j = 0; j < 4; ++j) o[64 * j] = pk4_fp8(clamp8(v[j][0] * hsc), clamp8(v[j][1] * hsc), clamp8(v[j][2] * hsc), clamp8(v[j][3] * hsc));
        float lg[8];
#pragma unroll
        for (int e = 0; e < 8; ++e) lg[e] = red[e] * rstd + rb[e];
        int e0 = 0; float v0 = lg[0];
#pragma unroll
        for (int e = 1; e < 8; ++e) if (lg[e] > v0) { v0 = lg[e]; e0 = e; }
        int e1 = -1; float v1 = -3.0e38f;
#pragma unroll
        for (int e = 0; e < 8; ++e) if (e != e0 && lg[e] > v1) { v1 = lg[e]; e1 = e; }
        const float w0 = 1.0f / (1.0f + expf(v1 - v0)), w1 = 1.0f - w0;
        if (F.lane == 0) { selE[tl] = e0 | (e1 << 4); selW[tl * 2] = w0; selW[tl * 2 + 1] = w1;
            ((int*)(F.ws + WS_SELE))[m] = e0 | (e1 << 4); ((float*)(F.ws + WS_SELW))[2 * m] = w0; ((float*)(F.ws + WS_SELW))[2 * m + 1] = w1; }
    }
    __syncthreads();
    if (F.wave == 0) { const int se = selE[F.lane], e0 = se & 15, e1 = se >> 4; int mine = 0;
#pragma unroll
        for (int e = 0; e < 8; ++e) { const int c = __popcll(__ballot(e0 == e)) + __popcll(__ballot(e1 == e)); mine = (F.lane == e) ? c : mine; }
        if (F.lane < 8) ((int*)(F.ws + WS_CNTG))[F.bid * 8 + F.lane] = mine; }
}
__device__ __forceinline__ void build_panels(Frame& F) {
    LAS int* cn = (LAS int*)F.lds;
    LAS int* pexp = (LAS int*)(F.lds + T_PEXP); LAS int* tt = (LAS int*)(F.lds + T_TOT);
    const int* cg = (const int*)(F.ws + WS_CNTG);
    for (int i = F.tid; i < F.G * 8; i += 512) cn[i] = cg[i];
    __syncthreads();
    { const int e = F.tid & 7, j = F.tid >> 3; int tot = 0, off = 0;
      for (int b = j; b < F.G; b += 64) { const int c = cn[b * 8 + e]; tot += c; off += (b < F.bid) ? c : 0; }
#pragma unroll
      for (int o = 8; o < 64; o <<= 1) { tot += __shfl_xor(tot, o); off += __shfl_xor(off, o); }
      LAS int* part = cn + 2048;
      if (F.lane < 8) { part[F.wave * 16 + F.lane] = tot; part[F.wave * 16 + 8 + F.lane] = off; }
      __syncthreads();
      if (F.tid < 16) { int v = 0;
#pragma unroll
          for (int w = 0; w < 8; ++w) v += part[w * 16 + F.tid];
          tt[F.tid] = v; } }
    __syncthreads();
    if (F.tid == 0) { int p = 0; for (int e = 0; e < 8; ++e) { const int np = (tt[e] + 255) >> 8; tt[16 + e] = p * 256; tt[24 + e] = np; p += np; } pexp[MOE_PANELS] = p; }
    __syncthreads();
    if (F.tid < MOE_PANELS) { int e = 0;
#pragma unroll
        for (int k = 1; k < 8; ++k) e += (F.tid * 256 >= tt[16 + k]) ? 1 : 0;
        pexp[F.tid] = e; }
    __syncthreads();
}
__device__ __forceinline__ void t_perm(Frame& F) {
    build_panels(F);
    LAS int* selE = (LAS int*)(F.lds + T_SELE); LAS float* selW = (LAS float*)(F.lds + T_SELW); LAS int* tt = (LAS int*)(F.lds + T_TOT);
    if (F.tid < 64) selE[F.tid] = ((const int*)(F.ws + WS_SELE))[F.bid * 64 + F.tid];
    if (F.tid < 128) selW[F.tid] = ((const float*)(F.ws + WS_SELW))[F.bid * 128 + F.tid];
    __syncthreads();
    int* rowtok = (int*)(F.ws + WS_ROWTOK); float* roww = (float*)(F.ws + WS_ROWW); int* tokpos = (int*)(F.ws + WS_TOKPOS);
    if (F.wave == 0) {
        const int i = F.lane, se = selE[i], e0 = se & 15, e1 = se >> 4, m = F.bid * 64 + i; const unsigned long long lt = (1ull << i) - 1ull;
#pragma unroll
        for (int e = 0; e < 8; ++e) { const unsigned long long m0 = __ballot(e0 == e), m1 = __ballot(e1 == e); const int base = tt[16 + e] + tt[8 + e];
            if (e0 == e) { const int pos = base + __popcll(m0 & lt); rowtok[pos] = m; roww[pos] = selW[i * 2]; tokpos[m * 2] = pos; }
            if (e1 == e) { const int pos = base + __popcll(m0) + __popcll(m1 & lt); rowtok[pos] = m; roww[pos] = selW[i * 2 + 1]; tokpos[m * 2 + 1] = pos; } } }
    if (F.bid < 8 && F.tid >= 64 && F.tid < 320) { const int e = F.bid, r = tt[e] + (F.tid - 64); if (r < tt[24 + e] * 256) { rowtok[tt[16 + e] + r] = 0; roww[tt[16 + e] + r] = 0.f; } }
}
__device__ __forceinline__ void t_conv(Frame& F, bf16* BB, const bf16* UC, const float* cw, int rank, int nranks) {
    if (rank < 0) return;
    const int gt = rank * 512 + F.tid, NT = nranks * 512, c8 = (gt & 127) * 8;
    f32x4 w[3][2];
#pragma unroll
    for (int k = 0; k < 3; ++k) { w[k][0] = *(const f32x4*)(cw + k * D + c8); w[k][1] = *(const f32x4*)(cw + k * D + c8 + 4); }
    for (int idx = gt; idx < M * 128; idx += 2 * NT) {
        v4u ld[2][4]; bool ok[2];
#pragma unroll
        for (int q = 0; q < 2; ++q) { const int id2 = idx + q * NT; ok[q] = id2 < M * 128; const int m = (ok[q] ? id2 : idx) >> 7, tpos = m & (SEQ - 1); const size_t off = (size_t)m * D + c8;
            ld[q][0] = *(const v4u*)(UC + off); ld[q][1] = *(const v4u*)(UC + off - (tpos >= 1 ? D : 0)); ld[q][2] = *(const v4u*)(UC + off - (tpos >= 2 ? 2 * D : 0)); ld[q][3] = *(const v4u*)(BB + off); }
#pragma unroll
        for (int q = 0; q < 2; ++q) { const int id2 = idx + q * NT; if (!ok[q]) continue; const int m = id2 >> 7, tpos = m & (SEQ - 1); const size_t off = (size_t)m * D + c8;
            f32x4 a0, a1, x0, x1; unpack8(ld[q][0], x0, x1); a0 = w[2][0] * x0; a1 = w[2][1] * x1;
            unpack8(ld[q][1], x0, x1); if (tpos >= 1) { a0 += w[1][0] * x0; a1 += w[1][1] * x1; }
            unpack8(ld[q][2], x0, x1); if (tpos >= 2) { a0 += w[0][0] * x0; a1 += w[0][1] * x1; }
            unpack8(ld[q][3], x0, x1);
            *(v4u*)(BB + off) = pack8(a0 * x0, a1 * x1); }
    }
}
__device__ __forceinline__ void t_carry4(Frame& F, int l, int pm, int g, const float* SL, bf16* UB) {
    LAS float* sl = (LAS float*)F.lds;
#pragma unroll
    for (int j = 0; j < 16; ++j) { const int i4 = F.tid + 512 * j, ck = i4 >> 5, q = i4 & 31;
        *(LAS f32x4*)(sl + i4 * 4) = *(const f32x4*)(SL + ((size_t)(pm * 256 + ck) * NG + g) * 128 + 4 * q); }
    __syncthreads();
    if (F.wave < 4) { const int n = F.lane, bb = F.wave; const f32x2 a = ((const f32x2*)(F.ws + WS_AT))[(l * NG + g) * 64 + n]; float sr = 0.f, si = 0.f;
        for (int k = 0; k < 64; ++k) { const int ck = bb * 64 + k; bf16* dst = UB + ((size_t)(pm * 256 + ck) * NG + g) * KY + 512;
            const unsigned pr = cvt_pk_bf16(sr, si); dst[n] = (bf16)(pr & 0xffffu); dst[64 + n] = (bf16)(pr >> 16);
            const float lr = sl[ck * 128 + n], li = sl[ck * 128 + 64 + n]; const float nr = a.x * sr - a.y * si + lr, ni = a.x * si + a.y * sr + li; sr = nr; si = ni; } }
    __syncthreads();
}
template <int MODE> __device__ __forceinline__ void t_combine_final(Frame& F, const bf16* XB, float* OUT, const bf16* O, const bf16* P, const float* gvec, int rank, int nranks) {
    if (rank < 0) return;
    const int gw = rank * 8 + F.wave, NGW = nranks * 8; const int* tokpos = (const int*)(F.ws + WS_TOKPOS);
    f32x4 g[4];
#pragma unroll
    for (int j = 0; j < 4; ++j) g[j] = ((const f32x4*)gvec)[F.lane + 64 * j];
    for (int m = gw; m < M; m += NGW) {
        const int p0 = tokpos[2 * m], p1 = tokpos[2 * m + 1]; const bool late = (p0 >= 32768) || (p1 >= 32768);
        if (late != (MODE == 1)) continue;
        f32x4* xr = (f32x4*)(OUT + (size_t)m * D) + F.lane; const v2u* xb = (const v2u*)(XB + (size_t)m * D) + F.lane;
        f32x4 v[4]; float s = 0.f;
#pragma unroll
        for (int j = 0; j < 4; ++j) { const v2u c = xb[64 * j]; v[j] = (f32x4){bf_lo(c.x), bf_hi(c.x), bf_lo(c.y), bf_hi(c.y)}; }
#pragma unroll
        for (int sl = 0; sl < 2; ++sl) { const int p = sl ? p1 : p0;
            if (MODE == 1 && p >= 32768) { const v2u* q0 = (const v2u*)(P + (size_t)(p - 32768) * D) + F.lane; const v2u* q1 = q0 + (size_t)2048 * D / 4;
#pragma unroll
                for (int j = 0; j < 4; ++j) { const v2u a = q0[64 * j], b = q1[64 * j]; v[j] += (f32x4){bf_lo(a.x), bf_hi(a.x), bf_lo(a.y), bf_hi(a.y)} + (f32x4){bf_lo(b.x), bf_hi(b.x), bf_lo(b.y), bf_hi(b.y)}; } }
            else { const v2u* o = (const v2u*)(O + (size_t)p * D) + F.lane;
#pragma unroll
                for (int j = 0; j < 4; ++j) { const v2u a = o[64 * j]; v[j] += (f32x4){bf_lo(a.x), bf_hi(a.x), bf_lo(a.y), bf_hi(a.y)}; } } }
#pragma unroll
        for (int j = 0; j < 4; ++j) s += (v[j][0] * v[j][0] + v[j][1] * v[j][1]) + (v[j][2] * v[j][2] + v[j][3] * v[j][3]);
        const float rstd = 1.0f / sqrtf(wave_sum(s) * (1.0f / D) + RMS_EPS);
#pragma unroll
        for (int j = 0; j < 4; ++j) xr[64 * j] = v[j] * rstd * g[j];
    }
}

#ifndef PHMASK
#define PHMASK 0xFFFFFFFFu
#endif
#define EN(k) ((PHMASK >> (k)) & 1u)
#ifndef DUPMASK
#define DUPMASK 0u
#endif
#define REP(k) for (int rep_ = 0; rep_ < 1 + (int)((DUPMASK >> (k)) & 1u); ++rep_)
#define IN(p) (lo <= (p) && (p) < hi)
#ifndef PROBE_A
#define PROBE_A (-2)
#define PROBE_B (-2)
#define PROBE_MULT 0
#endif
#define PSTAMP(p) do { if ((PROBE_A) == (p) || (PROBE_B) == (p)) { if (threadIdx.x == 0) { const unsigned long long t_ = __builtin_amdgcn_s_memrealtime(); volatile LAS unsigned* m_ = (volatile LAS unsigned*)((LAS unsigned char*)lds_raw + T_MISC); \
    if ((PROBE_A) == (p)) { m_[16] = (unsigned)t_; m_[17] = (unsigned)(t_ >> 32); } if ((PROBE_B) == (p)) { m_[18] = (unsigned)t_; m_[19] = (unsigned)(t_ >> 32); } } } } while (0)
#define SEAM(p) do { if (multi && (p) + 1 < hi) xcd_barrier(bar); PSTAMP(p); } while (0)
#define RING ((LAS unsigned char*)lds_raw)
template <int L> __device__ __forceinline__ void layer_phases(const int lo0, const int hi0, const bool multi, const XcdBarrier& bar, unsigned char* lds_raw) {
    constexpr int l = L;
    int lo = lo0, hi = hi0, G = gridDim.x, cidx = blockIdx.x; asm volatile("" : "+s"(lo), "+s"(hi), "+s"(G), "+s"(cidx));
    {
        const int pb = 1 + 16 * l;
        if (IN(pb + 1) && EN(2)) REP(2) {
            unsigned char* ws = KWS;
            SchedPlain S; S.o.init(M / 256, PW / 256, G, cidx); S.A = (const char*)(ws + WS_XB); S.B = (const char*)(ws + WS_WIN) + (size_t)l * PW * D * 2; S.tA = (size_t)256 * D * 2; S.tB = (size_t)256 * D * 2;
            EpiProj E{(bf16*)(ws + WS_BB), (bf16*)(ws + WS_UC), (bf16*)(ws + WS_UB), (bf16*)(ws + WS_GC), (bf16*)(ws + WS_GS), RING, (const float*)(ws + WS_SSQ)};
            { MKFRAME(F); prep_rstd(F, S.o, (const float*)(ws + WS_SSQ)); prep_bias(F, KIN(3) + (size_t)l * PW); }
            pg8::gemm_phase<EpiProj, SchedPlain, false, true>(RING, D * 2, D * 2, D * 2, S, E);
            { int pm_, pn_; if (!S.o.tile(5, pm_, pn_)) { MKFRAME(F); __syncthreads(); for (int job = cidx - 128; job >= 0 && job < NG * 4; job += 128) p0_ssm_job(F, l, job >> 2, job & 3);
                if (G == 256 && cidx >= 128) tr_window(F, l, 0, cidx - 128); } }
            SEAM(pb + 1);
        }
        if (IN(pb + 2) && EN(3)) REP(3) {
            unsigned char* ws = KWS;
            { SchedSsmS S; S.o.init(2, NG, G, cidx); S.UB = (const char*)(ws + WS_UB); S.BTS = (const char*)(ws + WS_BTS) + (size_t)l * NG * 128 * 512 * 2;
              EpiSloc E{(float*)(ws + WS_HN + 16 * MiB)};
              pg8::gemm_phase<EpiSloc, SchedSsmS, false, true>(RING, 512 * 2, NG * KY * 2, 512 * 2, S, E);
              { int pm_, g_; if (S.o.tile(0, pm_, g_)) { MKFRAME(F); t_carry4(F, l, pm_, g_, (const float*)(F.ws + WS_HN + 16 * MiB), (bf16*)(F.ws + WS_UB)); } } }
            { MKFRAME(F); t_conv(F, (bf16*)(F.ws + WS_BB), (const bf16*)(F.ws + WS_UC), KIN(4) + (size_t)l * 3 * D, G == 256 ? cidx - 64 : cidx, G == 256 ? 192 : G); }
            SEAM(pb + 2);
        }
        if (IN(pb + 4) && EN(5)) REP(5) {
            { unsigned char* ws = KWS;
              SchedSsmY S; S.o.init(2, 2 * NG, G, cidx); S.UB = (const char*)(ws + WS_UB); S.BTY = (const char*)(ws + WS_BTY) + (size_t)l * NG * 512 * KY * 2;
              EpiY E{(bf16*)(ws + WS_HN), (const bf16*)(ws + WS_UB), KIN(13) + (size_t)l * DSSM};
              pg8::gemm_phase<EpiY, SchedSsmY, false, true>(RING, KY * 2, NG * KY * 2, KY * 2, S, E); }
            { unsigned char* ws = KWS;
              SchedPlain S; S.o.init(M / 256, D / 256, G, cidx); S.A = (const char*)(ws + WS_BB); S.B = (const char*)(ws + WS_WCO) + (size_t)l * D * D * 2; S.tA = (size_t)256 * D * 2; S.tB = (size_t)256 * D * 2;
              EpiConvOut E{(bf16*)(ws + WS_GC)};
              pg8::gemm_phase<EpiConvOut, SchedPlain, false, true>(RING, D * 2, D * 2, D * 2, S, E); }
            if (G == 256 && cidx >= 128) { MKFRAME(F); __syncthreads(); tr_window(F, l, 1, cidx - 128); }
            SEAM(pb + 4);
        }
        if (IN(pb + 5) && EN(6)) REP(6) {
            unsigned char* ws = KWS;
            SchedPlain S; S.o.init(M / 256, 2048 / 256, G, cidx); S.A = (const char*)(ws + WS_HN); S.B = (const char*)(ws + WS_WGLU) + (size_t)l * 2048 * DSSM * 2; S.tA = (size_t)256 * DSSM * 2; S.tB = (size_t)256 * DSSM * 2;
            EpiGlu E{(bf16*)(ws + WS_GC), (const bf16*)(ws + WS_GS)};
            pg8::gemm_phase<EpiGlu, SchedPlain, false, true>(RING, DSSM * 2, DSSM * 2, DSSM * 2, S, E);
            SEAM(pb + 5);
        }
        if (IN(pb + 6) && EN(7)) REP(7) {
            unsigned char* ws = KWS;
            SchedPlain S; S.o.init(M / 256, D / 256, G, cidx); S.A = (const char*)(ws + WS_GC); S.B = (const char*)(ws + WS_WO) + (size_t)l * D * D * 2; S.tA = (size_t)256 * D * 2; S.tB = (size_t)256 * D * 2;
            EpiRes E{(bf16*)(ws + WS_XB), (float*)(ws + WS_SSQ)};
            pg8::gemm_phase<EpiRes, SchedPlain, false, true>(RING, D * 2, D * 2, D * 2, S, E);
            SEAM(pb + 6);
        }
        if (IN(pb + 7) && EN(8) && L == 1) REP(8) {
            MKFRAME(F);
            t_norm_router(F, (const bf16*)(F.ws + WS_XB), KIN(16) + D, (bf16*)(F.ws + WS_HN), KIN(20), KIN(21));
            SEAM(pb + 7);
        }
        if constexpr (L == 0) {
            if (IN(pb + 9) && EN(10)) REP(10) {
                unsigned char* ws = KWS;
                SchedPlain S; S.o.init(M / 256, 2 * DFF / 256, G, cidx); S.A = (const char*)(ws + WS_XB); S.B = (const char*)(ws + WS_WDGU); S.tA = (size_t)256 * D * 2; S.tB = (size_t)256 * D * 2;
                EpiSwiglu E{(bf16*)(ws + WS_HID), (const float*)(ws + WS_SSQ), RING};
                { MKFRAME(F); prep_rstd(F, S.o, (const float*)(ws + WS_SSQ)); }
                pg8::gemm_phase<EpiSwiglu, SchedPlain, false, true>(RING, D * 2, D * 2, D * 2, S, E);
                SEAM(pb + 9);
            }
            if (IN(pb + 10) && EN(11)) REP(11) {
                unsigned char* ws = KWS;
                SchedPlain S; S.o.init(M / 256, D / 256, G, cidx); S.A = (const char*)(ws + WS_HID); S.B = (const char*)(ws + WS_WDD); S.tA = (size_t)256 * DFF * 2; S.tB = (size_t)256 * DFF * 2;
                EpiRes E{(bf16*)(ws + WS_XB), (float*)(ws + WS_SSQ)};
                pg8::gemm_phase<EpiRes, SchedPlain, false, true>(RING, DFF * 2, DFF * 2, DFF * 2, S, E);
                SEAM(pb + 10);
            }
        } else {
            if (IN(pb + 8) && EN(9)) { MKFRAME(F); t_perm(F); SEAM(pb + 8); }
            const LAS int* pexp = (const LAS int*)(RING + T_PEXP);
            if (IN(pb + 9) && EN(12)) REP(12) {
                if (lo > pb + 8) { MKFRAME(F); build_panels(F); }
                unsigned char* ws = KWS;
                SchedMoe1 S; S.o.init(pexp[MOE_PANELS], 2 * DFF / 256, G, cidx); S.HN = (const char*)(ws + WS_HN); S.W = (const char*)(ws + WS_WMGU); S.rowtok = (const int*)(ws + WS_ROWTOK); S.pexp = pexp;
                EpiSwiglu8 E{(unsigned char*)(ws + WS_HID)};
                pg8::gemm_phase<EpiSwiglu8, SchedMoe1, true, true, true>(RING, D, D, D, S, E);
                SEAM(pb + 9);
            }
            if (IN(pb + 10) && EN(13)) REP(13) {
                if (lo > pb + 8) { MKFRAME(F); build_panels(F); }
                unsigned char* ws = KWS;
                SchedMoe2 S; S.o.init(128, D / 256, G, cidx); S.HID = (const char*)(ws + WS_HID); S.W = (const char*)(ws + WS_WMD); S.pexp = pexp;
                EpiMoeDown E{(bf16*)(ws + WS_MOEO), (const float*)(ws + WS_ROWW)};
                pg8::gemm_phase<EpiMoeDown, SchedMoe2, false, true, true>(RING, DFF, DFF, DFF, S, E);
                SEAM(pb + 10);
            }
            if (IN(pb + 11) && EN(14)) {
                if (lo > pb + 8) { MKFRAME(F); build_panels(F); }
                unsigned char* ws = KWS; const int nl = (pexp[MOE_PANELS] - 128) * 8;
                { SchedMoe2L S; S.nunits = nl; S.c = cidx; S.HID = (const char*)(ws + WS_HID); S.W = (const char*)(ws + WS_WMD); S.pexp = pexp;
                  EpiMoePart E{(bf16*)(ws + WS_HN), (const float*)(ws + WS_ROWW)};
                  pg8::gemm_phase<EpiMoePart, SchedMoe2L, false, true, true>(RING, DFF / 2, DFF, DFF, S, E); }
                { MKFRAME(F); const bool busy = cidx < nl; t_combine_final<0>(F, (const bf16*)(F.ws + WS_XB), KOUT, (const bf16*)(F.ws + WS_MOEO), (const bf16*)(F.ws + WS_HN), KIN(25), busy ? -1 : cidx - nl, G - nl); }
                SEAM(pb + 11);
            }
            if (IN(pb + 12) && EN(15)) { MKFRAME(F); t_combine_final<1>(F, (const bf16*)(F.ws + WS_XB), KOUT, (const bf16*)(F.ws + WS_MOEO), (const bf16*)(F.ws + WS_HN), KIN(25), cidx, G); }
        }
    }
}
struct Args { const float* in[26]; float* out; unsigned char* ws; int ph_lo, ph_hi; };
constexpr int N_PHASES = 1 + 32;
__global__ void __launch_bounds__(512, 2) fwd_kernel(Args args) {
    extern __shared__ __attribute__((aligned(16))) unsigned char lds_raw[];
    const int lo0 = args.ph_lo, hi0 = args.ph_hi; const bool multi = (hi0 - lo0) > 1;
    volatile LAS unsigned* MISC = (volatile LAS unsigned*)((LAS unsigned char*)lds_raw + T_MISC);
    if (threadIdx.x < 32) MISC[threadIdx.x] = 0u;
    __syncthreads();
    XcdBarrier bar; bar.bar = (unsigned*)(KWS + WS_CTL) + CW_BAR; bar.x = 0; bar.st = MISC + 8;
    if (multi) bar = xcd_barrier_post((unsigned*)(KWS + WS_CTL) + CW_BAR, MISC + 8);
    int lo = lo0, hi = hi0, G = gridDim.x, cidx = blockIdx.x;
    PSTAMP(-1);

    if (IN(0) && EN(0)) REP(0) {
        MKFRAME(F); unsigned char* ws = F.ws;
        p0_transposes(F);
        t_xcvt(F, KIN(0), (bf16*)(ws + WS_XB), (float*)(ws + WS_SSQ));
        SEAM(0);
    }
    layer_phases<0>(lo0, hi0, multi, bar, lds_raw);
    layer_phases<1>(lo0, hi0, multi, bar, lds_raw);
    PSTAMP(99);
    if (PROBE_MULT > 0 && blockIdx.x == 0 && threadIdx.x == 0) { volatile LAS unsigned* m_ = (volatile LAS unsigned*)((LAS unsigned char*)lds_raw + T_MISC);
        const unsigned long long a_ = ((unsigned long long)m_[17] << 32) | m_[16], b_ = ((unsigned long long)m_[19] << 32) | m_[18], e_ = __builtin_amdgcn_s_memrealtime();
        unsigned long long d_ = (b_ - a_) * (unsigned long long)PROBE_MULT; if (d_ > 400000ull) d_ = 400000ull;
        while (__builtin_amdgcn_s_memrealtime() - e_ < d_) __builtin_amdgcn_s_sleep(8); }
#undef IN
#undef REP
#undef EN
#undef SEAM
#undef RING
}

extern "C" void kernel_launch(void* const* d_in, const int* in_sizes, int n_in, void* d_out, int out_size, void* d_ws, size_t ws_size, hipStream_t stream) {
    static int grid = 0;
    if (grid == 0) {
        if (n_in != 26 || in_sizes[0] != M * D || out_size != M * D || ws_size < WS_END) { fprintf(stderr, "kernel_launch: unexpected shapes / workspace (%zu < %zu)\n", ws_size, (size_t)WS_END); grid = -1; return; }
        int dev = 0, cus = 0;
        if (hipGetDevice(&dev) != hipSuccess || hipDeviceGetAttribute(&cus, hipDeviceAttributeMultiprocessorCount, dev) != hipSuccess) { grid = -1; return; }
        if (hipFuncSetAttribute((const void*)fwd_kernel, hipFuncAttributeMaxDynamicSharedMemorySize, LDS_BYTES) != hipSuccess) { grid = -1; return; }
        (void)hipGetLastError();
        grid = 256;
        if (cus < 256) { fprintf(stderr, "kernel_launch: needs 256 CUs, device has %d\n", cus); grid = -1; return; }
    }
    if (grid < 0) return;
    Args a{};
    for (int i = 0; i < 26; ++i) a.in[i] = (const float*)d_in[i];
    a.out = (float*)d_out; a.ws = (unsigned char*)d_ws;
#if MK_PER_PHASE
    static const int phases[] = {0, 2, 3, 5, 6, 7, 10, 11, 18, 19, 21, 22, 23, 24, 25, 26, 27, 28, 29};
    for (int p : phases) {
        if (p == 1) continue;
        a.ph_lo = p; a.ph_hi = p + 1;
        hipLaunchKernelGGL(fwd_kernel, dim3(grid), dim3(512), LDS_BYTES, stream, a);
    }
#else
    (void)hipMemsetAsync((char*)d_ws + WS_CTL, 0, CTL_ZERO_BYTES, stream);
    a.ph_lo = 0; a.ph_hi = N_PHASES;
    hipLaunchKernelGGL(fwd_kernel, dim3(grid), dim3(512), LDS_BYTES, stream, a);
#endif
}
```

```cpp
#include <hip/hip_runtime.h>
#include <cstdio>
#include <cstdint>

#ifndef MK_PER_PHASE
#define MK_PER_PHASE 0
#endif

constexpr int M = 16384, D = 1024, SEQ = 2048, PW = 5632, DFF = 3584, NE = 8, DSSM = 512;
constexpr int TCH = 32, NCH = M / TCH, NG = 32, KY = 640;
constexpr int MOE_ROWS = 34816, MOE_PANELS = 136;
constexpr float RMS_EPS = 1e-6f;

namespace pg8 {
#define PG8_LAS __attribute__((address_space(3)))
typedef unsigned short bf16_t;
typedef short bf16x8 __attribute__((ext_vector_type(8)));
typedef float f32x4 __attribute__((ext_vector_type(4)));
typedef float f32x2 __attribute__((ext_vector_type(2)));
typedef unsigned u32x4 __attribute__((ext_vector_type(4)));
typedef unsigned u32x2 __attribute__((ext_vector_type(2)));
constexpr int BM = 256, BK = 64, HALF = 128, HTB = HALF * BK * 2, STAGE_BYTES = 8 * HTB, NXCD = 8, WGM = 4;

__host__ __device__ __forceinline__ int lds_byte(int r, int c) { const int st = (r >> 4) * 2 + (c >> 5), rr = r & 15, cc = c & 31, ob = rr * 64 + cc * 2; return st * 1024 + (ob ^ (((ob >> 9) & 1) << 5)); }
__host__ __device__ __forceinline__ void stage_rc(int b, int& R, int& C) { const int st = b / 1024, sb = b % 1024, swz = sb ^ (((sb >> 9) & 1) << 5); R = (st >> 1) * 16 + swz / 64; C = (st & 1) * 32 + (swz % 64) / 2; }
__host__ __device__ __forceinline__ int perm32(int rho) { const int n = rho >> 4, i = rho & 15; return 8 * (i >> 2) + 4 * n + (i & 3); }

struct Unit { int pm, pn, aux; const char* A; const char* B; const int* tok; };

struct Order {
    int nM, nN, nwg, G, c;
    __device__ __forceinline__ void init(int nM_, int nN_, int G_, int c_) { nM = nM_; nN = nN_; nwg = nM * nN; G = G_; c = c_; }
    __device__ __forceinline__ bool tile(int i, int& pm, int& pn) const {
        const long L = (long)i * G + c; if (L >= nwg) return false;
        int wgid = (int)L; { const int q = nwg / NXCD, r = nwg % NXCD, xcd = wgid % NXCD, off = wgid / NXCD; wgid = (xcd < r ? xcd * (q + 1) : r * (q + 1) + (xcd - r) * q) + off; }
        const int nig = WGM * nN, gid = wgid / nig, fm = gid * WGM, gsz = (nM - fm) < WGM ? (nM - fm) : WGM;
        pm = fm + ((wgid % nig) % gsz); pn = (wgid % nig) / gsz; return true;
    }
};

typedef int i32x4 __attribute__((ext_vector_type(4)));
typedef int i32x8 __attribute__((ext_vector_type(8)));
__device__ __forceinline__ i32x8 cat8(bf16x8 a, bf16x8 b) { return __builtin_shufflevector(__builtin_bit_cast(i32x4, a), __builtin_bit_cast(i32x4, b), 0, 1, 2, 3, 4, 5, 6, 7); }
__device__ __forceinline__ unsigned cvt_pk_bf16(float lo, float hi) { unsigned r; asm volatile("v_cvt_pk_bf16_f32 %0, %1, %2" : "=v"(r) : "v"(lo), "v"(hi)); return r; }
__device__ __forceinline__ float bf_lo(unsigned w) { return __uint_as_float(w << 16); }
__device__ __forceinline__ float bf_hi(unsigned w) { return __uint_as_float(w & 0xffff0000u); }
__device__ __forceinline__ float sigmoid_f(float x) { return __builtin_amdgcn_rcpf(1.0f + __builtin_amdgcn_exp2f(-1.4426950408889634f * x)); }
__device__ __forceinline__ f32x2 sig2(f32x2 x) { const f32x2 t = x * (-1.4426950408889634f); f32x2 e; e.x = __builtin_amdgcn_exp2f(t.x); e.y = __builtin_amdgcn_exp2f(t.y); e = e + 1.0f; f32x2 r; r.x = __builtin_amdgcn_rcpf(e.x); r.y = __builtin_amdgcn_rcpf(e.y); return r; }
__device__ __forceinline__ f32x4 sig4(f32x4 x) { const f32x2 a = sig2((f32x2){x[0], x[1]}), b = sig2((f32x2){x[2], x[3]}); return (f32x4){a.x, a.y, b.x, b.y}; }
__device__ __forceinline__ float gelu_tanh_f(float x) { const float t = 0.7978845608028654f * (x + 0.044715f * x * x * x); return x * sigmoid_f(2.0f * t); }

template <class Epi, class Sched, bool GATHER = false, bool ALIGN_EPI = true, bool FP8 = false>
__device__ __forceinline__ void gemm_phase(PG8_LAS unsigned char* lds, const int KB  , const unsigned lda, const unsigned ldb, const Sched& S, const Epi& E) {
    int tid_ = threadIdx.x; asm volatile("" : "+v"(tid_));
    const int tid = tid_, wid = __builtin_amdgcn_readfirstlane(tid >> 6), lane = tid & 63, wr = wid >> 2, wc = wid & 3, fr = lane & 15, fq = lane >> 4;
    const int nt = KB / (BK * 2);
    unsigned voffA[2], voffB[2], colA[2]; int rowA[2];
#pragma unroll
    for (int i = 0; i < 2; ++i) { int R, C; stage_rc(tid * 16 + i * 8192, R, C); const int Rb = Epi::PERM ? ((R & ~31) + perm32(R & 31)) : R;
        voffA[i] = (unsigned)R * lda + (unsigned)C * 2u; voffB[i] = (unsigned)Rb * ldb + (unsigned)C * 2u; rowA[i] = R; colA[i] = (unsigned)C * 2u; }
    const size_t kstep = (size_t)(BK * 2);
    const size_t hstepA = (size_t)HALF * lda, hstepB = (size_t)HALF * ldb;
    const unsigned ldsw = (unsigned)wid * 1024u;
    const int aoff = lds_byte(wr * 64 + fr, fq * 8), boff = lds_byte(wc * 32 + fr, fq * 8);
    unsigned gofc[2][2], gofn[2][2]; int gtok[2][2] = {{0, 0}, {0, 0}};
#define PG8_SA(b, h) (((b) * 2 + (h)) * HTB)
#define PG8_SB(b, h) ((4 + (b) * 2 + (h)) * HTB)
#define PG8_STAGE_B(bufoff, kbase, h) do { _Pragma("unroll") for (int _i = 0; _i < 2; ++_i) \
        __builtin_amdgcn_global_load_lds((const unsigned*)((const char*)(kbase) + (h) * hstepB + voffB[_i]), (PG8_LAS unsigned*)(lds + (bufoff) + ldsw + _i * 8192), 16, 0, 0); } while (0)
#define PG8_STAGE_A(bufoff, kbase, h, NX) do { _Pragma("unroll") for (int _i = 0; _i < 2; ++_i) { \
        const char* _p; if constexpr (GATHER) _p = (const char*)(kbase) + ((NX) ? gofn[h][_i] : gofc[h][_i]); else _p = (const char*)(kbase) + (h) * hstepA + voffA[_i]; \
        __builtin_amdgcn_global_load_lds((const unsigned*)_p, (PG8_LAS unsigned*)(lds + (bufoff) + ldsw + _i * 8192), 16, 0, 0); } } while (0)
#define PG8_LDA(dst, b, h) do { _Pragma("unroll") for (int m = 0; m < 4; ++m) { const bf16x8 _x = *(const PG8_LAS bf16x8*)(lds + PG8_SA(b, h) + aoff + m * 2048), _y = *(const PG8_LAS bf16x8*)(lds + PG8_SA(b, h) + aoff + m * 2048 + 1024); \
        if constexpr (FP8) dst##8[m] = cat8(_x, _y); else { dst[m][0] = _x; dst[m][1] = _y; } } } while (0)
#define PG8_LDB(dst, b, h) do { _Pragma("unroll") for (int n = 0; n < 2; ++n) { const bf16x8 _x = *(const PG8_LAS bf16x8*)(lds + PG8_SB(b, h) + boff + n * 2048), _y = *(const PG8_LAS bf16x8*)(lds + PG8_SB(b, h) + boff + n * 2048 + 1024); \
        if constexpr (FP8) dst##8[n] = cat8(_x, _y); else { dst[n][0] = _x; dst[n][1] = _y; } } } while (0)
#define PG8_MMA(ai, bj, At, Bt) do { __builtin_amdgcn_s_setprio(1); _Pragma("unroll") for (int m = 0; m < 4; ++m) _Pragma("unroll") for (int n = 0; n < 2; ++n) { \
        if constexpr (FP8) asm volatile("v_mfma_f32_16x16x128_f8f6f4 %0, %1, %2, %0" : "+v"(acc[ai][bj][m][n]) : "v"(Bt##8[n]), "v"(At##8[m]));     \
        else { _Pragma("unroll") for (int k = 0; k < 2; ++k) acc[ai][bj][m][n] = __builtin_amdgcn_mfma_f32_16x16x32_bf16(Bt[n][k], At[m][k], acc[ai][bj][m][n], 0, 0, 0); } } __builtin_amdgcn_s_setprio(0); } while (0)
#define PG8_WAIT_V(n) asm volatile("s_waitcnt vmcnt(" #n ")" ::: "memory")
#define PG8_WAIT_L(n) asm volatile("s_waitcnt lgkmcnt(" #n ")" ::: "memory")
#define PG8_BAR __builtin_amdgcn_s_barrier()
#define PG8_SCHED __builtin_amdgcn_sched_barrier(0)
    Unit cur, nxt; int ui = 0;
    if (!S.next(0, cur)) return;
    if constexpr (GATHER) {
#pragma unroll
        for (int h = 0; h < 2; ++h)
#pragma unroll
            for (int i = 0; i < 2; ++i) { gofc[h][i] = (unsigned)cur.tok[rowA[i] + HALF * h] * lda + colA[i]; gofn[h][i] = gofc[h][i]; }
    }
    f32x4 acc[2][2][4][2];
#pragma unroll
    for (int a = 0; a < 2; ++a)
#pragma unroll
        for (int b = 0; b < 2; ++b)
#pragma unroll
            for (int m = 0; m < 4; ++m)
#pragma unroll
                for (int n = 0; n < 2; ++n) acc[a][b][m][n] = (f32x4){0.f, 0.f, 0.f, 0.f};
    bf16x8 At[4][2], B0[2][2], B1[2][2]; i32x8 At8[4], B08[2], B18[2];
    const char* cA = cur.A; const char* cB = cur.B;
    PG8_STAGE_B(PG8_SB(0, 0), cB, 0); PG8_STAGE_B(PG8_SB(0, 1), cB, 1); PG8_STAGE_A(PG8_SA(0, 0), cA, 0, false); PG8_STAGE_A(PG8_SA(0, 1), cA, 1, false);
    if (wr == 1) PG8_BAR;
    PG8_WAIT_V(2); PG8_BAR;
    PG8_STAGE_B(PG8_SB(1, 0), cB + kstep, 0); PG8_STAGE_A(PG8_SA(1, 0), cA + kstep, 0, false); PG8_STAGE_B(PG8_SB(1, 1), cB + kstep, 1);
    PG8_WAIT_V(6); PG8_BAR;
    for (;;) {
        const bool has_next = S.next(ui + 1, nxt);
        const char* nA = has_next ? nxt.A : cA; const char* nB = has_next ? nxt.B : cB;
        for (int t = 0; t < nt; t += 2) {
            const bool last = (t == nt - 2);
            const char* a1 = cA + (size_t)(t + 1) * kstep;
            const char* a2 = last ? nA : cA + (size_t)(t + 2) * kstep; const char* b2 = last ? nB : cB + (size_t)(t + 2) * kstep;
            const char* a3 = a2 + kstep; const char* b3 = b2 + kstep;
            if constexpr (GATHER) {
                if (t == 0 && has_next) {
#pragma unroll
                    for (int h = 0; h < 2; ++h)
#pragma unroll
                        for (int i = 0; i < 2; ++i) gtok[h][i] = nxt.tok[rowA[i] + HALF * h]; }
                if (last && has_next) {
#pragma unroll
                    for (int h = 0; h < 2; ++h)
#pragma unroll
                        for (int i = 0; i < 2; ++i) gofn[h][i] = (unsigned)gtok[h][i] * lda + colA[i]; } }
            PG8_LDB(B0, 0, 0); PG8_LDB(B1, 0, 1); PG8_SCHED; PG8_LDA(At, 0, 0); PG8_STAGE_A(PG8_SA(1, 1), a1, 1, false);
            PG8_WAIT_V(8); PG8_WAIT_L(0); PG8_BAR; PG8_MMA(0, 0, At, B0); PG8_MMA(0, 1, At, B1); PG8_BAR; PG8_SCHED;
            PG8_LDA(At, 0, 1); PG8_STAGE_B(PG8_SB(0, 0), b2, 0); PG8_STAGE_B(PG8_SB(0, 1), b2, 1); PG8_STAGE_A(PG8_SA(0, 0), a2, 0, last);
            PG8_WAIT_V(8); PG8_WAIT_L(0); PG8_BAR; PG8_MMA(1, 0, At, B0); PG8_MMA(1, 1, At, B1); PG8_BAR; PG8_SCHED;
            PG8_LDB(B0, 1, 0); PG8_LDB(B1, 1, 1); PG8_SCHED; PG8_LDA(At, 1, 0); PG8_STAGE_A(PG8_SA(0, 1), a2, 1, last);
            PG8_WAIT_V(8); PG8_WAIT_L(0); PG8_BAR; PG8_MMA(0, 0, At, B0); PG8_MMA(0, 1, At, B1); PG8_BAR; PG8_SCHED;
            PG8_LDA(At, 1, 1); PG8_STAGE_B(PG8_SB(1, 0), b3, 0); PG8_STAGE_B(PG8_SB(1, 1), b3, 1); PG8_STAGE_A(PG8_SA(1, 0), a3, 0, last);
            PG8_WAIT_V(8); PG8_WAIT_L(0); PG8_BAR; PG8_MMA(1, 0, At, B0); PG8_MMA(1, 1, At, B1); PG8_BAR; PG8_SCHED;
        }
        if constexpr (ALIGN_EPI) { if (wr == 0) PG8_BAR; }
        if constexpr (FP8) {
            asm volatile("s_nop 15\n\ts_nop 7" : "+v"(acc[0][0][0][0]), "+v"(acc[0][0][0][1]), "+v"(acc[0][0][1][0]), "+v"(acc[0][0][1][1]), "+v"(acc[0][0][2][0]), "+v"(acc[0][0][2][1]), "+v"(acc[0][0][3][0]), "+v"(acc[0][0][3][1]),
                         "+v"(acc[0][1][0][0]), "+v"(acc[0][1][0][1]), "+v"(acc[0][1][1][0]), "+v"(acc[0][1][1][1]), "+v"(acc[0][1][2][0]), "+v"(acc[0][1][2][1]), "+v"(acc[0][1][3][0]), "+v"(acc[0][1][3][1]));
            asm volatile("" : "+v"(acc[1][0][0][0]), "+v"(acc[1][0][0][1]), "+v"(acc[1][0][1][0]), "+v"(acc[1][0][1][1]), "+v"(acc[1][0][2][0]), "+v"(acc[1][0][2][1]), "+v"(acc[1][0][3][0]), "+v"(acc[1][0][3][1]),
                         "+v"(acc[1][1][0][0]), "+v"(acc[1][1][0][1]), "+v"(acc[1][1][1][0]), "+v"(acc[1][1][1][1]), "+v"(acc[1][1][2][0]), "+v"(acc[1][1][2][1]), "+v"(acc[1][1][3][0]), "+v"(acc[1][1][3][1])); }
        E(acc, cur, wr, wc, fr, fq);
        if (!has_next) break;
#pragma unroll
        for (int a = 0; a < 2; ++a)
#pragma unroll
            for (int b = 0; b < 2; ++b)
#pragma unroll
                for (int m = 0; m < 4; ++m)
#pragma unroll
                    for (int n = 0; n < 2; ++n) acc[a][b][m][n] = (f32x4){0.f, 0.f, 0.f, 0.f};
        cur = nxt; cA = nA; cB = nB; ++ui;
        if constexpr (GATHER) {
#pragma unroll
            for (int h = 0; h < 2; ++h)
#pragma unroll
                for (int i = 0; i < 2; ++i) gofc[h][i] = gofn[h][i];
        }
        if constexpr (ALIGN_EPI) { if (wr == 1) PG8_BAR; }
    }
    PG8_WAIT_V(0);
    if constexpr (!ALIGN_EPI) { if (wr == 0) PG8_BAR; }
    PG8_BAR;
#undef PG8_SA
#undef PG8_SB
#undef PG8_STAGE_A
#undef PG8_STAGE_B
#undef PG8_LDA
#undef PG8_LDB
#undef PG8_MMA
#undef PG8_WAIT_V
#undef PG8_WAIT_L
#undef PG8_BAR
#undef PG8_SCHED
}
}

constexpr size_t MiB = 1u << 20;
constexpr size_t WS_CTL = 0, CTL_ZERO_BYTES = 64 * 1024;
constexpr size_t WS_SELE = 1 * MiB;
constexpr size_t WS_SELW = WS_SELE + 64 * 1024;
constexpr size_t WS_CNTG = WS_SELW + 128 * 1024;
constexpr size_t WS_ROWTOK = WS_CNTG + 8 * 1024;
constexpr size_t WS_ROWW = WS_ROWTOK + 160 * 1024;
constexpr size_t WS_TOKPOS = WS_ROWW + 160 * 1024;
constexpr size_t WS_AT = WS_TOKPOS + 128 * 1024;
static_assert(WS_AT + 32 * 1024 <= 4 * MiB, "tables");
constexpr size_t WS_WMGU = 4 * MiB;
constexpr size_t WS_WMD = 60 * MiB;
constexpr size_t WS_HN = 88 * MiB;
constexpr size_t WS_ACT = 120 * MiB;
constexpr size_t WS_BB = WS_ACT;
constexpr size_t WS_UC = WS_ACT + 32 * MiB;
constexpr size_t WS_UB = WS_ACT + 64 * MiB;
constexpr size_t WS_GC = WS_ACT + 84 * MiB;
constexpr size_t WS_GS = WS_ACT + 116 * MiB;
constexpr size_t WS_HID = WS_ACT;
constexpr size_t WS_MOEO = 240 * MiB;
constexpr size_t WS_WDGU = 268 * MiB;
constexpr size_t WS_WDD = 282 * MiB;
constexpr size_t WS_BTY = 289 * MiB;
constexpr size_t WS_BTS = 329 * MiB;
constexpr size_t WS_WIN = 338 * MiB;
constexpr size_t WS_WCO = 360 * MiB, WS_WGLU = 364 * MiB, WS_WO = 368 * MiB;
constexpr size_t WS_XB = 372 * MiB;
constexpr size_t WS_SSQ = 404 * MiB;
constexpr size_t WS_XB8 = 405 * MiB;
constexpr size_t WS_END = 421 * MiB;
static_assert(WS_HID + (size_t)MOE_ROWS * DFF <= WS_MOEO && WS_MOEO + (size_t)MOE_ROWS * D * 2 <= WS_END && WS_GS + 32 * MiB <= WS_WDGU, "map: the MoE buffers overlay the mixer activations and non-MoE weight copies (all dead by then)");
constexpr int CW_BAR = 1024;

constexpr int RING_BYTES = 131072, TAB_OFF = RING_BYTES;
constexpr int T_MISC = TAB_OFF;
constexpr int T_SELE = TAB_OFF + 128;
constexpr int T_SELW = T_SELE + 256;
constexpr int T_PEXP = T_SELW + 512;
constexpr int T_TOT = T_PEXP + 4 * (MOE_PANELS + 8);
constexpr int T_BIAS = 133120;
constexpr int T_RSTD = T_BIAS + 4 * PW;
constexpr int T_RMAP = T_RSTD + 4096;
constexpr int LDS_BYTES = 163840;
static_assert(T_TOT + 128 <= T_BIAS && T_RMAP + 16 <= LDS_BYTES, "LDS map");

#define GAS __attribute__((address_space(1)))
#define LAS __attribute__((address_space(3)))
typedef unsigned short bf16;
typedef unsigned v4u __attribute__((ext_vector_type(4)));
typedef unsigned v2u __attribute__((ext_vector_type(2)));
typedef float f32x4 __attribute__((ext_vector_type(4)));
typedef float f32x2 __attribute__((ext_vector_type(2)));
#define LDS_WAIT() asm volatile("s_waitcnt lgkmcnt(0)" ::: "memory")
using pg8::cvt_pk_bf16; using pg8::bf_lo; using pg8::bf_hi; using pg8::sigmoid_f; using pg8::gelu_tanh_f; using pg8::sig4;

#define XB_TMO      128
#define XB_XCNT(j)  (256  + 64 * (j))
#define XB_XSUB(j)  (1280 + 64 * (j))
#define XB_XGEN(j)  (2304 + 64 * (j))
#define XB_TOP      3328
#define XB_TOPGEN   3392
#define XCD_BAR_WORDS 3456
#define XB_SPIN_CAP (1u << 18)
__device__ __forceinline__ unsigned xb_ld(unsigned* p)              { return __hip_atomic_load(p, __ATOMIC_RELAXED, __HIP_MEMORY_SCOPE_AGENT); }
__device__ __forceinline__ unsigned xb_add(unsigned* p, unsigned v) { return __hip_atomic_fetch_add(p, v, __ATOMIC_RELAXED, __HIP_MEMORY_SCOPE_AGENT); }
__device__ __forceinline__ unsigned xb_xcc_id() { return (unsigned)__builtin_amdgcn_s_getreg((3 << 11) | 20) & 0xFu; }
#define XB_SPIN(cond, bar) do { unsigned _sp = 0; while (cond) { __builtin_amdgcn_s_sleep(1); \
    if ((++_sp & 255u) == 0u) { if (xb_ld(&(bar)[XB_TMO])) break; if (_sp > XB_SPIN_CAP) { atomicAdd(&(bar)[XB_TMO], 1u); break; } } } } while (0)
struct XcdBarrier { unsigned* bar; unsigned x; volatile LAS unsigned* st; };
__device__ __forceinline__ XcdBarrier xcd_barrier_post(unsigned* bar, volatile LAS unsigned* st) {
    XcdBarrier b; b.bar = bar; b.x = xb_xcc_id(); b.st = st;
    if (threadIdx.x == 0) (void)xb_add(&bar[XB_XCNT(b.x)], 1u);
    return b;
}
__device__ __forceinline__ void xcd_barrier_complete(unsigned* bar, unsigned x, unsigned& nloc, unsigned& nx) {
    const unsigned G = gridDim.x * gridDim.y * gridDim.z;
    unsigned sum, cnt, mine, sp = 0u;
    for (;;) {
        sum = 0u; cnt = 0u; mine = 0u;
#pragma unroll
        for (unsigned j = 0; j < 16; ++j) { const unsigned c = xb_ld(&bar[XB_XCNT(j)]); sum += c; cnt += (c > 0u) ? 1u : 0u; mine = (j == x) ? c : mine; }
        if (sum == G) break;
        __builtin_amdgcn_s_sleep(1);
        if ((++sp & 255u) == 0u) { if (xb_ld(&bar[XB_TMO])) break; if (sp > XB_SPIN_CAP) { atomicAdd(&bar[XB_TMO], 1u); break; } }
    }
    nloc = mine > 0u ? mine : 1u; nx = cnt > 0u ? cnt : 1u;
}
__device__ __forceinline__ void xcd_barrier(const XcdBarrier& b) {
    asm volatile("s_waitcnt vmcnt(0)" ::: "memory");
    __syncthreads();
    if (threadIdx.x == 0) {
        unsigned* bar = b.bar;
        __builtin_amdgcn_s_waitcnt(0);
        unsigned nloc = b.st[0], nx = b.st[1];
        if (nloc == 0u) { xcd_barrier_complete(bar, b.x, nloc, nx); b.st[0] = nloc; b.st[1] = nx; }
        const unsigned old = xb_add(&bar[XB_XSUB(b.x)], 1u);
        const unsigned gen = old / nloc;
        if (old + 1u == (gen + 1u) * nloc) {
            __builtin_amdgcn_fence(__ATOMIC_RELEASE, "agent");
            asm volatile("s_waitcnt vmcnt(0)" ::: "memory");
            const unsigned og = xb_add(&bar[XB_TOP], 1u);
            const unsigned tg = og / nx;
            if (og + 1u == (tg + 1u) * nx) xb_add(&bar[XB_TOPGEN], 1u);
            else XB_SPIN(xb_ld(&bar[XB_TOPGEN]) == tg, bar);
            __builtin_amdgcn_fence(__ATOMIC_ACQUIRE, "agent");
            xb_add(&bar[XB_XGEN(b.x)], 1u);
            asm volatile("s_waitcnt vmcnt(0)" ::: "memory");
        } else {
            XB_SPIN(xb_ld(&bar[XB_XGEN(b.x)]) == gen, bar);
            __builtin_amdgcn_fence(__ATOMIC_ACQUIRE, "agent");
            asm volatile("s_waitcnt vmcnt(0)" ::: "memory");
        }
    }
    __syncthreads();
}

struct Frame {
    LAS unsigned char* lds;
    int tid, lane, wave, bid, vcu, G;
    unsigned char* ws;
};
typedef const void* kcvp_t;
__device__ __forceinline__ const void* karg_ptr(int off) { const __attribute__((address_space(4))) char* b = (const __attribute__((address_space(4))) char*)__builtin_amdgcn_kernarg_segment_ptr(); asm volatile("" : "+s"(b)); return *(const __attribute__((address_space(4))) kcvp_t*)(b + off); }
#define KIN(i) ((const float*)karg_ptr(8 * (i)))
#define KOUT ((float*)karg_ptr(208))
#define KWS ((unsigned char*)karg_ptr(216))
#define MKFRAME(F) Frame F; { int t_ = threadIdx.x; asm volatile("" : "+v"(t_)); F.lds = (LAS unsigned char*)lds_raw; F.tid = t_; F.lane = t_ & 63; F.wave = __builtin_amdgcn_readfirstlane(t_ >> 6); \
    { int g_ = gridDim.x, b_ = blockIdx.x; asm volatile("" : "+s"(g_), "+s"(b_)); F.G = g_; F.bid = b_; } F.vcu = (F.G % 8 == 0) ? (F.bid % 8) * (F.G / 8) + F.bid / 8 : F.bid; F.ws = KWS; }

template <int CTRL> __device__ __forceinline__ float dpp_f(float v) { return __int_as_float(__builtin_amdgcn_update_dpp(0, __float_as_int(v), CTRL, 0xF, 0xF, true)); }
__device__ __forceinline__ float wave_sum(float v) {
#pragma unroll
    for (int o = 1; o < 64; o <<= 1) v += __shfl_xor(v, o);
    return v;
}

__device__ __forceinline__ void prep_rstd(Frame& F, const pg8::Order& o, const float* SSQ) {
    LAS int* map = (LAS int*)(F.lds + T_RMAP); LAS float* rl = (LAS float*)(F.lds + T_RSTD);
    int p0 = -1, p1 = -1, p2 = -1, p3 = -1, np = 0;
    for (int i = 0; ; ++i) { int pm, pn; if (!o.tile(i, pm, pn)) break;
        if (pm == p0 || pm == p1 || pm == p2 || pm == p3) continue;
        if (np == 0) p0 = pm; else if (np == 1) p1 = pm; else if (np == 2) p2 = pm; else if (np == 3) p3 = pm;
        ++np; }
    if (F.tid == 0) { map[0] = p0; map[1] = p1; map[2] = p2; map[3] = p3; }
#pragma unroll
    for (int it = 0; it < 2; ++it) { const int sl = 2 * it + (F.tid >> 8); const int ps = sl == 0 ? p0 : sl == 1 ? p1 : sl == 2 ? p2 : p3;
        if (ps >= 0) { const int t = F.tid & 255; const f32x4* p = (const f32x4*)(SSQ + (size_t)(ps * 256 + t) * 16); const f32x4 a = p[0], b = p[1], c = p[2], d = p[3];
            const float q = ((a[0] + a[1]) + (a[2] + a[3])) + ((b[0] + b[1]) + (b[2] + b[3])) + ((c[0] + c[1]) + (c[2] + c[3])) + ((d[0] + d[1]) + (d[2] + d[3]));
            rl[sl * 256 + t] = 1.0f / sqrtf(q * (1.0f / D) + RMS_EPS); } }
    __syncthreads();
}
__device__ __forceinline__ void prep_bias(Frame& F, const float* bias) {
    LAS float* bl = (LAS float*)(F.lds + T_BIAS);
    for (int i = F.tid; i < PW; i += 512) bl[i] = bias[i];
    __syncthreads();
}
struct SchedPlain {
    pg8::Order o; const char* A; const char* B; size_t tA, tB;
    __device__ __forceinline__ bool next(int i, pg8::Unit& u) const { int pm, pn; if (!o.tile(i, pm, pn)) return false; u.pm = pm; u.pn = pn; u.aux = 0; u.A = A + (size_t)pm * tA; u.B = B + (size_t)pn * tB; u.tok = nullptr; return true; }
};
struct SchedSsmY {
    pg8::Order o; const char* UB; const char* BTY;
    __device__ __forceinline__ bool next(int i, pg8::Unit& u) const { int pm, pnn; if (!o.tile(i, pm, pnn)) return false; const int g = pnn >> 1; u.pm = pm; u.pn = pnn & 1; u.aux = g;
        u.A = UB + (size_t)pm * 256 * (NG * KY * 2) + (size_t)g * (KY * 2); u.B = BTY + (size_t)pnn * 256 * (KY * 2); u.tok = nullptr; return true; }
};
struct SchedSsmS {
    pg8::Order o; const char* UB; const char* BTS;
    __device__ __forceinline__ bool next(int i, pg8::Unit& u) const { int pm, g; if (!o.tile(i, pm, g)) return false; u.pm = pm; u.pn = 0; u.aux = g;
        u.A = UB + (size_t)pm * 256 * (NG * KY * 2) + (size_t)g * (KY * 2); u.B = BTS + (size_t)g * 128 * (512 * 2); u.tok = nullptr; return true; }
};
struct SchedMoe1 {
    pg8::Order o; const char* HN; const char* W; const int* rowtok; const LAS int* pexp;
    __device__ __forceinline__ bool next(int i, pg8::Unit& u) const { int pm, pn; if (!o.tile(i, pm, pn)) return false; const int e = pexp[pm]; u.pm = pm; u.pn = pn; u.aux = e;
        u.A = HN; u.B = W + (size_t)e * (2 * DFF) * D + (size_t)pn * 256 * D; u.tok = rowtok + pm * 256; return true; }
};
struct SchedMoe2 {
    pg8::Order o; const char* HID; const char* W; const LAS int* pexp;
    __device__ __forceinline__ bool next(int i, pg8::Unit& u) const { int pm, pn; if (!o.tile(i, pm, pn)) return false; const int e = pexp[pm]; u.pm = pm; u.pn = pn; u.aux = e;
        u.A = HID + (size_t)pm * 256 * DFF; u.B = W + (size_t)e * D * DFF + (size_t)pn * 256 * DFF; u.tok = nullptr; return true; }
};

struct SchedMoe2L {
    int nunits, c; const char* HID; const char* W; const LAS int* pexp;
    __device__ __forceinline__ bool next(int i, pg8::Unit& u) const { if (i > 0 || c >= nunits) return false; const int pm = 128 + (c >> 3), pn = (c >> 1) & 3, kh = c & 1, e = pexp[pm];
        u.pm = pm; u.pn = pn; u.aux = kh; u.A = HID + (size_t)pm * 256 * DFF + (size_t)kh * (DFF / 2); u.B = W + (size_t)e * D * DFF + (size_t)pn * 256 * DFF + (size_t)kh * (DFF / 2); u.tok = nullptr; return true; }
};
using pg8::Unit; using pg8::HALF; using pg8::BM;
typedef const f32x4 (&AccRef)[2][2][4][2];
constexpr int HN_SH = 4, WGU_SH = 7, HID_SH = 3, WD_SH = 8, XB8_SH = 4;
__device__ __forceinline__ float clamp8(float v) { return __builtin_fminf(__builtin_fmaxf(v, -440.0f), 440.0f); }
__device__ __forceinline__ unsigned pk4_fp8(float a, float b, float c, float d) { unsigned w = 0u; w = (unsigned)__builtin_amdgcn_cvt_pk_fp8_f32(a, b, (int)w, false); w = (unsigned)__builtin_amdgcn_cvt_pk_fp8_f32(c, d, (int)w, true); return w; }
__device__ __forceinline__ v4u pack8(const f32x4 a, const f32x4 b) { v4u w; w.x = cvt_pk_bf16(a[0], a[1]); w.y = cvt_pk_bf16(a[2], a[3]); w.z = cvt_pk_bf16(b[0], b[1]); w.w = cvt_pk_bf16(b[2], b[3]); return w; }
__device__ __forceinline__ void unpack8(const v4u w, f32x4& a, f32x4& b) { a = (f32x4){bf_lo(w.x), bf_hi(w.x), bf_lo(w.y), bf_hi(w.y)}; b = (f32x4){bf_lo(w.z), bf_hi(w.z), bf_lo(w.w), bf_hi(w.w)}; }

__device__ __forceinline__ void row_rstd(const float* SSQ, const LAS unsigned char* lds, int pm, int rloc, float (&rs)[2][4]) {
    const LAS int* map = (const LAS int*)(lds + T_RMAP); const LAS float* rl = (const LAS float*)(lds + T_RSTD);
    const int sl = map[0] == pm ? 0 : map[1] == pm ? 1 : map[2] == pm ? 2 : map[3] == pm ? 3 : -1;
    if (sl >= 0) {
#pragma unroll
        for (int ai = 0; ai < 2; ++ai)
#pragma unroll
            for (int m = 0; m < 4; ++m) rs[ai][m] = rl[sl * 256 + rloc + ai * HALF + m * 16];
    } else {
#pragma unroll
        for (int ai = 0; ai < 2; ++ai)
#pragma unroll
            for (int m = 0; m < 4; ++m) { const f32x4* p = (const f32x4*)(SSQ + (size_t)(pm * BM + rloc + ai * HALF + m * 16) * 16); const f32x4 a = p[0], b = p[1], c = p[2], d = p[3];
                const float t = ((a[0] + a[1]) + (a[2] + a[3])) + ((b[0] + b[1]) + (b[2] + b[3])) + ((c[0] + c[1]) + (c[2] + c[3])) + ((d[0] + d[1]) + (d[2] + d[3]));
                rs[ai][m] = 1.0f / sqrtf(t * (1.0f / D) + RMS_EPS); }
    }
}
struct EpiProj {
    static constexpr bool PERM = true;
    bf16* BB; bf16* UC; bf16* UB; bf16* GC; bf16* GS; const LAS unsigned char* lds; const float* SSQ;
    __device__ __forceinline__ void operator()(AccRef acc, const Unit& u, int wr, int wc, int fr, int fq) const {
        const int row0 = u.pm * BM + wr * 64 + fr, cl = wc * 32 + 8 * fq, pn = u.pn;
        float rs[2][4]; row_rstd(SSQ, lds, u.pm, wr * 64 + fr, rs); const LAS float* bias = (const LAS float*)(lds + T_BIAS);
        if (pn >= 4 && pn < 12) {
            const int q = pn - 4, ch = 128 * q + cl;
            const f32x4 bc0 = *(const LAS f32x4*)(bias + 1024 + ch), bc1 = *(const LAS f32x4*)(bias + 1024 + ch + 4), bv0 = *(const LAS f32x4*)(bias + 2048 + ch), bv1 = *(const LAS f32x4*)(bias + 2048 + ch + 4);
#pragma unroll
            for (int ai = 0; ai < 2; ++ai)
#pragma unroll
                for (int m = 0; m < 4; ++m) { const int row = row0 + ai * HALF + m * 16;
                    const float r = rs[ai][m]; const f32x4 p0 = (acc[ai][0][m][0] * r + bc0) * (acc[ai][1][m][0] * r + bv0), p1 = (acc[ai][0][m][1] * r + bc1) * (acc[ai][1][m][1] * r + bv1);
                    *(v4u*)(UC + (size_t)row * D + ch) = pack8(p0, p1); }
            return;
        }
#pragma unroll
        for (int bj = 0; bj < 2; ++bj) {
            const int dcol = pn * BM + bj * HALF + cl;
            const f32x4 b0 = *(const LAS f32x4*)(bias + dcol), b1 = *(const LAS f32x4*)(bias + dcol + 4);
#pragma unroll
            for (int ai = 0; ai < 2; ++ai)
#pragma unroll
                for (int m = 0; m < 4; ++m) { const int row = row0 + ai * HALF + m * 16;
                    f32x4 v0 = acc[ai][bj][m][0] * rs[ai][m] + b0, v1 = acc[ai][bj][m][1] * rs[ai][m] + b1;
                    if (pn < 4) { *(v4u*)(BB + (size_t)row * D + dcol) = pack8(v0, v1); }
                    else if (pn < 14) { const int cu = dcol - 3072, g = cu >> 4, cp = cu & 15;
                        *(v4u*)(UB + ((size_t)(row >> 5) * NG + g) * KY + (row & 31) * 16 + cp) = pack8(v0, v1); }
                    else {
                        v0 = sig4(v0); v1 = sig4(v1);
                        if (pn < 18) *(v4u*)(GC + (size_t)row * D + (dcol - 3584)) = pack8(v0, v1);
                        else *(v4u*)(GS + (size_t)row * D + (dcol - 4608)) = pack8(v0, v1); } }
        }
    }
};
struct EpiSloc {
    static constexpr bool PERM = false;
    float* SL;
    __device__ __forceinline__ void operator()(AccRef acc, const Unit& u, int wr, int wc, int fr, int fq) const {
        const int row0 = u.pm * BM + wr * 64 + fr, col0 = wc * 32 + 4 * fq;
#pragma unroll
        for (int ai = 0; ai < 2; ++ai)
#pragma unroll
            for (int m = 0; m < 4; ++m) { float* p = SL + ((size_t)(row0 + ai * HALF + m * 16) * NG + u.aux) * 128 + col0;
#pragma unroll
                for (int n = 0; n < 2; ++n) *(f32x4*)(p + n * 16) = acc[ai][0][m][n]; }
    }
};
struct EpiY {
    static constexpr bool PERM = true;
    bf16* YB; const bf16* UB; const float* dsk;
    __device__ __forceinline__ void operator()(AccRef acc, const Unit& u, int wr, int wc, int fr, int fq) const {
        const int row0 = u.pm * BM + wr * 64 + fr, g = u.aux;
#pragma unroll
        for (int bj = 0; bj < 2; ++bj) {
            const int col = u.pn * BM + bj * HALF + wc * 32 + 8 * fq, j = col >> 4, c = col & 15, ch = g * 16 + c;
            const f32x4 d0 = *(const f32x4*)(dsk + ch), d1 = *(const f32x4*)(dsk + ch + 4);
#pragma unroll
            for (int ai = 0; ai < 2; ++ai)
#pragma unroll
                for (int m = 0; m < 4; ++m) { const int chunk = row0 + ai * HALF + m * 16;
                    const v4u uw = *(const v4u*)(UB + ((size_t)chunk * NG + g) * KY + j * 16 + c); f32x4 u0, u1; unpack8(uw, u0, u1);
                    f32x4 v0 = acc[ai][bj][m][0] + d0 * u0, v1 = acc[ai][bj][m][1] + d1 * u1;
#pragma unroll
                    for (int k = 0; k < 4; ++k) { v0[k] = gelu_tanh_f(v0[k]); v1[k] = gelu_tanh_f(v1[k]); }
                    *(v4u*)(YB + ((size_t)chunk * TCH + j) * DSSM + ch) = pack8(v0, v1); }
        }
    }
};
struct EpiConvOut {
    static constexpr bool PERM = true;
    bf16* GC;
    __device__ __forceinline__ void operator()(AccRef acc, const Unit& u, int wr, int wc, int fr, int fq) const {
        const int row0 = u.pm * BM + wr * 64 + fr;
#pragma unroll
        for (int ai = 0; ai < 2; ++ai)
#pragma unroll
            for (int m = 0; m < 4; ++m)
#pragma unroll
                for (int bj = 0; bj < 2; ++bj) { bf16* p = GC + (size_t)(row0 + ai * HALF + m * 16) * D + u.pn * BM + bj * HALF + wc * 32 + 8 * fq;
                    f32x4 g0, g1; unpack8(*(const v4u*)p, g0, g1); *(v4u*)p = pack8(g0 * acc[ai][bj][m][0], g1 * acc[ai][bj][m][1]); }
    }
};
struct EpiGlu {
    static constexpr bool PERM = true;
    bf16* P1; const bf16* GS;
    __device__ __forceinline__ void operator()(AccRef acc, const Unit& u, int wr, int wc, int fr, int fq) const {
        const int row0 = u.pm * BM + wr * 64 + fr, ch = u.pn * HALF + wc * 32 + 8 * fq;
#pragma unroll
        for (int ai = 0; ai < 2; ++ai)
#pragma unroll
            for (int m = 0; m < 4; ++m) { const size_t off = (size_t)(row0 + ai * HALF + m * 16) * D + ch;
                f32x4 p0, p1, s0, s1; unpack8(*(const v4u*)(P1 + off), p0, p1); unpack8(*(const v4u*)(GS + off), s0, s1);
                f32x4 z0 = acc[ai][0][m][0], z1 = acc[ai][0][m][1]; const f32x4 y0 = acc[ai][1][m][0], y1 = acc[ai][1][m][1];
                z0 = p0 + s0 * z0 * sig4(y0); z1 = p1 + s1 * z1 * sig4(y1);
                *(v4u*)(P1 + off) = pack8(z0, z1); }
    }
};
struct EpiRes {
    static constexpr bool PERM = true;
    bf16* XB; float* SSQ; unsigned char* XB8; float ascale;
    __device__ __forceinline__ void operator()(AccRef acc, const Unit& u, int wr, int wc, int fr, int fq) const {
        const int row0 = u.pm * BM + wr * 64 + fr, col0 = u.pn * BM + wc * 32 + 8 * fq; const float xs = (float)(1 << XB8_SH);
#pragma unroll
        for (int ai = 0; ai < 2; ++ai)
#pragma unroll
            for (int m = 0; m < 4; ++m) { const int row = row0 + ai * HALF + m * 16; float s = 0.f;
#pragma unroll
                for (int bj = 0; bj < 2; ++bj) { bf16* p = XB + (size_t)row * D + col0 + bj * HALF; f32x4 x0, x1; unpack8(*(const v4u*)p, x0, x1);
                    x0 += acc[ai][bj][m][0] * ascale; x1 += acc[ai][bj][m][1] * ascale; *(v4u*)p = pack8(x0, x1);
                    if (XB8) { v2u w8; w8.x = pk4_fp8(clamp8(x0[0] * xs), clamp8(x0[1] * xs), clamp8(x0[2] * xs), clamp8(x0[3] * xs)); w8.y = pk4_fp8(clamp8(x1[0] * xs), clamp8(x1[1] * xs), clamp8(x1[2] * xs), clamp8(x1[3] * xs)); *(v2u*)(XB8 + (size_t)row * D + col0 + bj * HALF) = w8; }
                    s += ((x0[0] * x0[0] + x0[1] * x0[1]) + (x0[2] * x0[2] + x0[3] * x0[3])) + ((x1[0] * x1[0] + x1[1] * x1[1]) + (x1[2] * x1[2] + x1[3] * x1[3])); }
                s += __shfl_xor(s, 16); s += __shfl_xor(s, 32);
                if (fq == 0) SSQ[(size_t)row * 16 + u.pn * 4 + wc] = s; }
    }
};
struct EpiSwiglu {
    static constexpr bool PERM = true;
    bf16* H; const float* SSQ; const LAS unsigned char* lds;
    __device__ __forceinline__ void operator()(AccRef acc, const Unit& u, int wr, int wc, int fr, int fq) const {
        const int row0 = u.pm * BM + wr * 64 + fr, ch = u.pn * HALF + wc * 32 + 8 * fq;
        float rs[2][4]; row_rstd(SSQ, lds, u.pm, wr * 64 + fr, rs);
#pragma unroll
        for (int ai = 0; ai < 2; ++ai)
#pragma unroll
            for (int m = 0; m < 4; ++m) { const float r = rs[ai][m], r2 = r * r; f32x4 g0 = acc[ai][0][m][0], g1 = acc[ai][0][m][1]; const f32x4 u0 = acc[ai][1][m][0], u1 = acc[ai][1][m][1];
                g0 = (g0 * u0) * (sig4(g0 * r) * r2); g1 = (g1 * u1) * (sig4(g1 * r) * r2);
                *(v4u*)(H + (size_t)(row0 + ai * HALF + m * 16) * DFF + ch) = pack8(g0, g1); }
    }
};
struct EpiSwiglu8d {
    static constexpr bool PERM = true;
    unsigned char* H; const float* SSQ; const LAS unsigned char* lds;
    __device__ __forceinline__ void operator()(AccRef acc, const Unit& u, int wr, int wc, int fr, int fq) const {
        const int row0 = u.pm * BM + wr * 64 + fr, ch = u.pn * HALF + wc * 32 + 8 * fq; const float si = 1.0f / (float)(1 << (XB8_SH + WGU_SH)), sc = (float)(1 << HID_SH);
        float rs[2][4]; row_rstd(SSQ, lds, u.pm, wr * 64 + fr, rs);
#pragma unroll
        for (int ai = 0; ai < 2; ++ai)
#pragma unroll
            for (int m = 0; m < 4; ++m) { const float r = rs[ai][m] * si; f32x4 g0 = acc[ai][0][m][0], g1 = acc[ai][0][m][1]; const f32x4 u0 = acc[ai][1][m][0], u1 = acc[ai][1][m][1];
                g0 = (g0 * u0) * (sig4(g0 * r) * (r * r * sc)); g1 = (g1 * u1) * (sig4(g1 * r) * (r * r * sc));
#pragma unroll
                for (int k = 0; k < 4; ++k) { g0[k] = clamp8(g0[k]); g1[k] = clamp8(g1[k]); }
                v2u w; w.x = pk4_fp8(g0[0], g0[1], g0[2], g0[3]); w.y = pk4_fp8(g1[0], g1[1], g1[2], g1[3]);
                *(v2u*)(H + (size_t)(row0 + ai * HALF + m * 16) * DFF + ch) = w; }
    }
};
struct EpiSwiglu8 {
    static constexpr bool PERM = true;
    unsigned char* H;
    __device__ __forceinline__ void operator()(AccRef acc, const Unit& u, int wr, int wc, int fr, int fq) const {
        const int row0 = u.pm * BM + wr * 64 + fr, ch = u.pn * HALF + wc * 32 + 8 * fq; const float sc = (float)(1 << HID_SH) / (float)(1 << (HN_SH + WGU_SH)), si = 1.0f / (float)(1 << (HN_SH + WGU_SH));
#pragma unroll
        for (int ai = 0; ai < 2; ++ai)
#pragma unroll
            for (int m = 0; m < 4; ++m) { f32x4 g0 = acc[ai][0][m][0], g1 = acc[ai][0][m][1]; const f32x4 u0 = acc[ai][1][m][0], u1 = acc[ai][1][m][1];
                g0 = (g0 * u0) * (sig4(g0 * si) * (sc * si)); g1 = (g1 * u1) * (sig4(g1 * si) * (sc * si));
#pragma unroll
                for (int k = 0; k < 4; ++k) { g0[k] = clamp8(g0[k]); g1[k] = clamp8(g1[k]); }
                v2u w; w.x = pk4_fp8(g0[0], g0[1], g0[2], g0[3]); w.y = pk4_fp8(g1[0], g1[1], g1[2], g1[3]);
                *(v2u*)(H + (size_t)(row0 + ai * HALF + m * 16) * DFF + ch) = w; }
    }
};
struct EpiMoeDown {
    static constexpr bool PERM = true;
    bf16* O; const float* roww;
    __device__ __forceinline__ void operator()(AccRef acc, const Unit& u, int wr, int wc, int fr, int fq) const {
        const int row0 = u.pm * BM + wr * 64 + fr;
#pragma unroll
        for (int ai = 0; ai < 2; ++ai)
#pragma unroll
            for (int m = 0; m < 4; ++m) { const int row = row0 + ai * HALF + m * 16; const float w = roww[row] * (1.0f / (float)(1 << (HID_SH + WD_SH)));
#pragma unroll
                for (int bj = 0; bj < 2; ++bj) *(v4u*)(O + (size_t)row * D + u.pn * BM + bj * HALF + wc * 32 + 8 * fq) = pack8(acc[ai][bj][m][0] * w, acc[ai][bj][m][1] * w); }
    }
};

struct EpiMoePart {
    static constexpr bool PERM = true;
    bf16* P; const float* roww;
    __device__ __forceinline__ void operator()(AccRef acc, const Unit& u, int wr, int wc, int fr, int fq) const {
        const int row0 = u.pm * BM + wr * 64 + fr; bf16* base = P + (size_t)u.aux * 2048 * D;
#pragma unroll
        for (int ai = 0; ai < 2; ++ai)
#pragma unroll
            for (int m = 0; m < 4; ++m) { const int row = row0 + ai * HALF + m * 16; const float w = roww[row] * (1.0f / (float)(1 << (HID_SH + WD_SH)));
#pragma unroll
                for (int bj = 0; bj < 2; ++bj) *(v4u*)(base + (size_t)(row - 32768) * D + u.pn * BM + bj * HALF + wc * 32 + 8 * fq) = pack8(acc[ai][bj][m][0] * w, acc[ai][bj][m][1] * w); }
    }
};
template <bool FP8> __device__ __forceinline__ void tr_item2(const float* W, int N, int k0, int n0, unsigned char* dst, size_t ld_bytes, int drow0, float scale, LAS unsigned* scr, int lane, const float* gk = nullptr) {
    float v[128];
    const float* src = W + (size_t)k0 * N + n0 + lane;
#pragma unroll
    for (int i = 0; i < 128; ++i) v[i] = __builtin_nontemporal_load(src + (size_t)i * N);
    if (gk) {
#pragma unroll
        for (int i = 0; i < 128; ++i) v[i] *= gk[k0 + i]; }
#pragma unroll
    for (int hlf = 0; hlf < (FP8 ? 1 : 2); ++hlf) {
        unsigned dw[32];
        if constexpr (FP8) {
#pragma unroll
            for (int i = 0; i < 32; ++i) dw[i] = pk4_fp8(v[4 * i] * scale, v[4 * i + 1] * scale, v[4 * i + 2] * scale, v[4 * i + 3] * scale);
        } else {
#pragma unroll
            for (int i = 0; i < 32; ++i) dw[i] = cvt_pk_bf16(v[hlf * 64 + 2 * i], v[hlf * 64 + 2 * i + 1]); }
#pragma unroll
        for (int i = 0; i < 8; ++i) *(LAS v4u*)(scr + lane * 36 + 4 * i) = (v4u){dw[4 * i], dw[4 * i + 1], dw[4 * i + 2], dw[4 * i + 3]};
        LDS_WAIT(); asm volatile("" ::: "memory");
        const int c = lane & 7; const size_t kb = FP8 ? (size_t)k0 : (size_t)(k0 + hlf * 64) * 2;
#pragma unroll
        for (int j = 0; j < 8; ++j) { const int r = (lane >> 3) + 8 * j; const v4u o = *(const LAS v4u*)(scr + r * 36 + 4 * c);
            __builtin_nontemporal_store(o, (GAS v4u*)(dst + (size_t)(drow0 + r) * ld_bytes + kb + 16 * c)); }
        LDS_WAIT(); asm volatile("" ::: "memory");
    }
}
__device__ __forceinline__ int pair_row(int ch, int second) { return (ch >> 7) * 256 + (ch & 127) + (second ? 128 : 0); }
constexpr int I_MGU = 8 * 56, I_MD = 28 * 16;
constexpr int N8 = 8 * (2 * I_MGU + I_MD);
#ifndef WIN_A
#define WIN_A 2
#define WIN_B 3
#endif
constexpr int WIN_PROJ = WIN_A, WIN_E = WIN_B;
constexpr int NDEFER = 2 * 1024 * (WIN_PROJ + WIN_E);
static_assert(NDEFER <= N8, "windows");
__device__ __forceinline__ void tr_moe_item(Frame& F, int r, LAS unsigned* scr) {
    unsigned char* ws = F.ws;
    const int e = r / (2 * I_MGU + I_MD); r %= (2 * I_MGU + I_MD);
    if (r < 2 * I_MGU) { const int sgu = r / I_MGU; r %= I_MGU; const int n0 = (r % 56) * 64;
        tr_item2<true>((sgu ? KIN(23) : KIN(22)) + (size_t)e * D * DFF, DFF, (r / 56) * 128, n0, ws + WS_WMGU + (size_t)e * 2 * DFF * D, D, pair_row(n0, sgu), (float)(1 << WGU_SH), scr, F.lane); }
    else { r -= 2 * I_MGU; tr_item2<true>(KIN(24) + (size_t)e * DFF * D, D, (r / 16) * 128, (r % 16) * 64, ws + WS_WMD + (size_t)e * D * DFF, DFF, (r % 16) * 64, (float)(1 << WD_SH), scr, F.lane); }
}
__device__ __forceinline__ void tr_window(Frame& F, int l, int kind, int rank) {
    LAS unsigned* scr = (LAS unsigned*)(F.lds + 49152 + F.wave * 9216);
    const int base = l * 1024 * (WIN_PROJ + WIN_E) + (kind ? 1024 * WIN_PROJ : 0), n = kind ? WIN_E : WIN_PROJ;
#pragma unroll 1
    for (int k = 0; k < n; ++k) tr_moe_item(F, base + k * 1024 + rank * 8 + F.wave, scr);
}
__device__ __forceinline__ void p0_transposes(Frame& F) {
    LAS unsigned* scr = (LAS unsigned*)(F.lds + 49152 + F.wave * 9216);
    const int gw = F.vcu * 8 + F.wave, NGW = F.G * 8;
    constexpr int I_IN = 8 * 88, I_SQ = 8 * 16, I_GLU = 4 * 32, I_GU = 8 * 56, I_DN = 28 * 16;
    constexpr int NIT = N8 + 2 * I_IN + 2 * I_SQ + 2 * I_GLU + 2 * I_SQ + 2 * I_GU + I_DN;
    unsigned char* ws = F.ws;
    for (int it = (F.G == 256 ? NDEFER : 0) + gw; it < NIT; it += NGW) {
        int r = it;
        if (r < N8) { tr_moe_item(F, r, scr); continue; }
        r -= N8;
        if (r < 2 * I_IN) { const int l = r / I_IN; r %= I_IN; const int n0 = (r % 88) * 64; int d = n0;
            if (n0 >= 1024 && n0 < 2048) d = 1024 + pair_row(n0 - 1024, 0); else if (n0 >= 2048 && n0 < 3072) d = 1024 + pair_row(n0 - 2048, 1);
            tr_item2<false>(KIN(2) + (size_t)l * D * PW, PW, (r / 88) * 128, n0, ws + WS_WIN + (size_t)l * PW * D * 2, D * 2, d, 1.f, scr, F.lane, KIN(1) + l * D); continue; }
        r -= 2 * I_IN;
        if (r < 2 * I_SQ) { const int l = r / I_SQ; r %= I_SQ; tr_item2<false>(KIN(5) + (size_t)l * D * D, D, (r / 16) * 128, (r % 16) * 64, ws + WS_WCO + (size_t)l * D * D * 2, D * 2, (r % 16) * 64, 1.f, scr, F.lane); continue; }
        r -= 2 * I_SQ;
        if (r < 2 * I_GLU) { const int l = r / I_GLU; r %= I_GLU; const int n0 = (r % 32) * 64; const int d = n0 < 1024 ? pair_row(n0, 0) : pair_row(n0 - 1024, 1);
            tr_item2<false>(KIN(14) + (size_t)l * DSSM * 2048, 2048, (r / 32) * 128, n0, ws + WS_WGLU + (size_t)l * 2048 * DSSM * 2, DSSM * 2, d, 1.f, scr, F.lane); continue; }
        r -= 2 * I_GLU;
        if (r < 2 * I_SQ) { const int l = r / I_SQ; r %= I_SQ; tr_item2<false>(KIN(15) + (size_t)l * D * D, D, (r / 16) * 128, (r % 16) * 64, ws + WS_WO + (size_t)l * D * D * 2, D * 2, (r % 16) * 64, 1.f, scr, F.lane); continue; }
        r -= 2 * I_SQ;
        if (r < 2 * I_GU) { const int sgu = r / I_GU; r %= I_GU; const int n0 = (r % 56) * 64;
            tr_item2<true>(sgu ? KIN(18) : KIN(17), DFF, (r / 56) * 128, n0, ws + WS_WDGU, D, pair_row(n0, sgu), (float)(1 << WGU_SH), scr, F.lane, KIN(16)); continue; }
        r -= 2 * I_GU;
        tr_item2<true>(KIN(19), D, (r / 16) * 128, (r % 16) * 64, ws + WS_WDD, DFF, (r % 16) * 64, (float)(1 << WD_SH), scr, F.lane);
    }
}
__device__ __forceinline__ void p0_ssm_job(Frame& F, int l, int g, int cq) {
    LAS f32x2* pw = (LAS f32x2*)(F.lds);
    LAS f32x2* bbL = pw + 33 * 64;
    LAS f32x2* CL = bbL + 64 * 16;
    LAS float* KmL = (LAS float*)(CL + 16 * 64);
    const int t = F.tid, lg = l * NG + g;
    const float* a_re = KIN(6); const float* a_im = KIN(7); const float* ldt = KIN(8); const float* b_re = KIN(9); const float* b_im = KIN(10); const float* c_re = KIN(11); const float* c_im = KIN(12);
    for (int idx = t; idx < 1024; idx += 512) CL[idx] = (f32x2){c_re[(size_t)lg * 1024 + idx], c_im[(size_t)lg * 1024 + idx]};
    if (t < 64) {
        const int n = t; const float ar = a_re[lg * 64 + n], ai = a_im[lg * 64 + n], dt = expf(ldt[lg]);
        const float mag = expf(ar * dt), ang = ai * dt; float sn, cs; sn = sinf(ang); cs = cosf(ang);
        const float are = mag * cs, aim = mag * sn, den = ar * ar + ai * ai, nr = are - 1.0f, ni = aim;
        const float cre = (nr * ar + ni * ai) / den, cim = (ni * ar - nr * ai) / den;
        float pr = 1.0f, pi = 0.0f; pw[n] = (f32x2){1.0f, 0.0f};
        for (int d = 1; d <= TCH; ++d) { const float qr = pr * are - pi * aim, qi = pr * aim + pi * are; pr = qr; pi = qi; pw[d * 64 + n] = (f32x2){pr, pi}; }
        if (cq == 0) ((f32x2*)(F.ws + WS_AT))[lg * 64 + n] = (f32x2){pr, pi};
#pragma unroll
        for (int c = 0; c < 16; ++c) { const float br = b_re[((size_t)lg * 64 + n) * 16 + c], bi = b_im[((size_t)lg * 64 + n) * 16 + c]; bbL[n * 16 + c] = (f32x2){cre * br - cim * bi, cre * bi + cim * br}; }
    }
    __syncthreads();
    { const int cp = t & 15, cc = (t >> 4) & 3, dq = t >> 6;
#pragma unroll
      for (int r = 0; r < 4; ++r) { const int d = dq * 4 + r; float s = 0.f;
          for (int n = 0; n < 64; ++n) { const f32x2 C = CL[(4 * cq + cc) * 64 + n], p = pw[d * 64 + n], b = bbL[n * 16 + cp];
              const float xr = C.x * p.x - C.y * p.y, xi = C.x * p.y + C.y * p.x; s += xr * b.x - xi * b.y; }
          KmL[(d * 4 + cc) * 16 + cp] = s; } }
    __syncthreads();
    const int q = F.lane, i = q >> 1, c0 = (q & 1) * 8;
    for (int rr = F.wave; rr < 128; rr += 8) {
        const int j = rr >> 2, cc = rr & 3, c = 4 * cq + cc;
        bf16* dst = (bf16*)(F.ws + WS_BTY) + ((size_t)lg * 512 + j * 16 + c) * KY;
        float v[8];
#pragma unroll
        for (int e = 0; e < 8; ++e) v[e] = (i <= j) ? KmL[((j - i) * 4 + cc) * 16 + c0 + e] : 0.0f;
        v4u o; o.x = cvt_pk_bf16(v[0], v[1]); o.y = cvt_pk_bf16(v[2], v[3]); o.z = cvt_pk_bf16(v[4], v[5]); o.w = cvt_pk_bf16(v[6], v[7]);
        *(GAS v4u*)(dst + q * 8) = o;
        if (q < 16) { const int part = q >> 3, n0 = (q & 7) * 8;
#pragma unroll
            for (int e = 0; e < 8; ++e) { const f32x2 C = CL[c * 64 + n0 + e], p = pw[(j + 1) * 64 + n0 + e]; v[e] = part ? -(C.x * p.y + C.y * p.x) : (C.x * p.x - C.y * p.y); }
            o.x = cvt_pk_bf16(v[0], v[1]); o.y = cvt_pk_bf16(v[2], v[3]); o.z = cvt_pk_bf16(v[4], v[5]); o.w = cvt_pk_bf16(v[6], v[7]);
            *(GAS v4u*)(dst + 512 + q * 8) = o; }
    }
    for (int rr = F.wave * 4; rr < F.wave * 4 + 4; ++rr) {
        const int part = rr >> 4, n = 16 * cq + (rr & 15);
        bf16* dst = (bf16*)(F.ws + WS_BTS) + ((size_t)lg * 128 + part * 64 + n) * 512;
        const f32x2 p = pw[(TCH - 1 - i) * 64 + n]; float v[8];
#pragma unroll
        for (int e = 0; e < 8; ++e) { const f32x2 b = bbL[n * 16 + c0 + e]; v[e] = part ? (p.x * b.y + p.y * b.x) : (p.x * b.x - p.y * b.y); }
        v4u o; o.x = cvt_pk_bf16(v[0], v[1]); o.y = cvt_pk_bf16(v[2], v[3]); o.z = cvt_pk_bf16(v[4], v[5]); o.w = cvt_pk_bf16(v[6], v[7]);
        *(GAS v4u*)(dst + q * 8) = o;
    }
    __syncthreads();
}

__device__ __forceinline__ void t_xcvt(Frame& F, const float* X, bf16* XB, float* SSQ) {
    const int gw = F.vcu * 8 + F.wave, NGW = F.G * 8;
    for (int m0 = gw * 4; m0 < M; m0 += NGW * 4) {
        f32x4 v[4][4];
#pragma unroll
        for (int r = 0; r < 4; ++r) { const f32x4* xr = (const f32x4*)(X + (size_t)(m0 + r) * D) + F.lane;
#pragma unroll
            for (int j = 0; j < 4; ++j) v[r][j] = __builtin_nontemporal_load(xr + 64 * j); }
#pragma unroll
        for (int r = 0; r < 4; ++r) { float s = 0.f;
#pragma unroll
            for (int j = 0; j < 4; ++j) s += (v[r][j][0] * v[r][j][0] + v[r][j][1] * v[r][j][1]) + (v[r][j][2] * v[r][j][2] + v[r][j][3] * v[r][j][3]);
            s = wave_sum(s);
            v2u* o = (v2u*)(XB + (size_t)(m0 + r) * D) + F.lane;
#pragma unroll
            for (int j = 0; j < 4; ++j) { v2u w; w.x = cvt_pk_bf16(v[r][j][0], v[r][j][1]); w.y = cvt_pk_bf16(v[r][j][2], v[r][j][3]); o[64 * j] = w; }
            if (F.lane < 16) SSQ[(size_t)(m0 + r) * 16 + F.lane] = F.lane == 0 ? s : 0.f; }
    }
}
__device__ __forceinline__ void t_norm_router(Frame& F, const bf16* X, const float* gvec, bf16* HN, const float* rw, const float* rb) {
    f32x4 g[4]; f32x4 rwv[4][4][2];
    {
        LAS float* rl = (LAS float*)F.lds;
#pragma unroll
        for (int i = 0; i < 4; ++i) { const int q = F.tid + 512 * i, k = q >> 1, hf = q & 1; *(LAS f32x4*)(rl + (k >> 2) * 36 + (k & 3) * 8 + hf * 4) = ((const f32x4*)rw)[q]; }
        __syncthreads();
#pragma unroll
        for (int j = 0; j < 4; ++j) { g[j] = ((const f32x4*)gvec)[F.lane + 64 * j];
#pragma unroll
            for (int c = 0; c < 4; ++c) { const LAS f32x4* p = (const LAS f32x4*)(rl + (j * 64 + F.lane) * 36 + c * 8); rwv[j][c][0] = p[0]; rwv[j][c][1] = p[1]; } }
    }
    LAS int* selE = (LAS int*)(F.lds + T_SELE); LAS float* selW = (LAS float*)(F.lds + T_SELW);
    v2u xin[8][4];
#pragma unroll
    for (int k = 0; k < 8; ++k) { const v2u* xr = (const v2u*)(X + (size_t)(F.bid * 64 + F.wave * 8 + k) * D) + F.lane;
#pragma unroll
        for (int j = 0; j < 4; ++j) xin[k][j] = xr[64 * j]; }
#pragma unroll
    for (int k = 0; k < 8; ++k) {
        const int tl = F.wave * 8 + k, m = F.bid * 64 + tl;
        f32x4 v[4]; float red[9];
#pragma unroll
        for (int e = 0; e < 9; ++e) red[e] = 0.f;
#pragma unroll
        for (int j = 0; j < 4; ++j) { const v2u a = xin[k][j]; v[j] = (f32x4){bf_lo(a.x), bf_hi(a.x), bf_lo(a.y), bf_hi(a.y)}; red[8] += (v[j][0] * v[j][0] + v[j][1] * v[j][1]) + (v[j][2] * v[j][2] + v[j][3] * v[j][3]);
            v[j] = v[j] * g[j];
#pragma unroll
            for (int c = 0; c < 4; ++c)
#pragma unroll
                for (int e = 0; e < 8; ++e) red[e] += v[j][c] * rwv[j][c][e >> 2][e & 3]; }
#pragma unroll
        for (int e = 0; e < 9; ++e) {
            red[e] += dpp_f<0xB1>(red[e]); red[e] += dpp_f<0x4E>(red[e]); red[e] += dpp_f<0x141>(red[e]); red[e] += dpp_f<0x140>(red[e]); }
#pragma unroll
        for (int o = 16; o < 64; o <<= 1) { float t[9];
#pragma unroll
            for (int e = 0; e < 9; ++e) t[e] = __shfl_xor(red[e], o);
#pragma unroll
            for (int e = 0; e < 9; ++e) red[e] += t[e]; }
        const float rstd = 1.0f / sqrtf(red[8] * (1.0f / D) + RMS_EPS);
        unsigned* o = (unsigned*)((unsigned char*)HN + (size_t)m * D) + F.lane; const float hsc = (float)(1 << HN_SH) * rstd;
#pragma unroll
        for (int j = 0; j < 4; ++j) o[64 * j] = pk4_fp8(clamp8(v[j][0] * hsc), clamp8(v[j][1] * hsc), clamp8(v[j][2] * hsc), clamp8(v[j][3] * hsc));
        float lg[8];
#pragma unroll
        for (int e = 0; e < 8; ++e) lg[e] = red[e] * rstd + rb[e];
        int e0 = 0; float v0 = lg[0];
#pragma unroll
        for (int e = 1; e < 8; ++e) if (lg[e] > v0) { v0 = lg[e]; e0 = e; }
        int e1 = -1; float v1 = -3.0e38f;
#pragma unroll
        for (int e = 0; e < 8; ++e) if (e != e0 && lg[e] > v1) { v1 = lg[e]; e1 = e; }
        const float w0 = 1.0f / (1.0f + expf(v1 - v0)), w1 = 1.0f - w0;
        if (F.lane == 0) { selE[tl] = e0 | (e1 << 4); selW[tl * 2] = w0; selW[tl * 2 + 1] = w1;
            ((int*)(F.ws + WS_SELE))[m] = e0 | (e1 << 4); ((float*)(F.ws + WS_SELW))[2 * m] = w0; ((float*)(F.ws + WS_SELW))[2 * m + 1] = w1; }
    }
    __syncthreads();
    if (F.wave == 0) { const int se = selE[F.lane], e0 = se & 15, e1 = se >> 4; int mine = 0;
#pragma unroll
        for (int e = 0; e < 8; ++e) { const int c = __popcll(__ballot(e0 == e)) + __popcll(__ballot(e1 == e)); mine = (F.lane == e) ? c : mine; }
        if (F.lane < 8) ((int*)(F.ws + WS_CNTG))[F.bid * 8 + F.lane] = mine; }
}
__device__ __forceinline__ void build_panels(Frame& F) {
    LAS int* cn = (LAS int*)F.lds;
    LAS int* pexp = (LAS int*)(F.lds + T_PEXP); LAS int* tt = (LAS int*)(F.lds + T_TOT);
    const int* cg = (const int*)(F.ws + WS_CNTG);
    for (int i = F.tid; i < F.G * 8; i += 512) cn[i] = cg[i];
    __syncthreads();
    { const int e = F.tid & 7, j = F.tid >> 3; int tot = 0, off = 0;
      for (int b = j; b < F.G; b += 64) { const int c = cn[b * 8 + e]; tot += c; off += (b < F.bid) ? c : 0; }
#pragma unroll
      for (int o = 8; o < 64; o <<= 1) { tot += __shfl_xor(tot, o); off += __shfl_xor(off, o); }
      LAS int* part = cn + 2048;
      if (F.lane < 8) { part[F.wave * 16 + F.lane] = tot; part[F.wave * 16 + 8 + F.lane] = off; }
      __syncthreads();
      if (F.tid < 16) { int v = 0;
#pragma unroll
          for (int w = 0; w < 8; ++w) v += part[w * 16 + F.tid];
          tt[F.tid] = v; } }
    __syncthreads();
    if (F.tid == 0) { int p = 0; for (int e = 0; e < 8; ++e) { const int np = (tt[e] + 255) >> 8; tt[16 + e] = p * 256; tt[24 + e] = np; p += np; } pexp[MOE_PANELS] = p; }
    __syncthreads();
    if (F.tid < MOE_PANELS) { int e = 0;
#pragma unroll
        for (int k = 1; k < 8; ++k) e += (F.tid * 256 >= tt[16 + k]) ? 1 : 0;
        pexp[F.tid] = e; }
    __syncthreads();
}
__device__ __forceinline__ void t_perm(Frame& F) {
    build_panels(F);
    LAS int* selE = (LAS int*)(F.lds + T_SELE); LAS float* selW = (LAS float*)(F.lds + T_SELW); LAS int* tt = (LAS int*)(F.lds + T_TOT);
    if (F.tid < 64) selE[F.tid] = ((const int*)(F.ws + WS_SELE))[F.bid * 64 + F.tid];
    if (F.tid < 128) selW[F.tid] = ((const float*)(F.ws + WS_SELW))[F.bid * 128 + F.tid];
    __syncthreads();
    int* rowtok = (int*)(F.ws + WS_ROWTOK); float* roww = (float*)(F.ws + WS_ROWW); int* tokpos = (int*)(F.ws + WS_TOKPOS);
    if (F.wave == 0) {
        const int i = F.lane, se = selE[i], e0 = se & 15, e1 = se >> 4, m = F.bid * 64 + i; const unsigned long long lt = (1ull << i) - 1ull;
#pragma unroll
        for (int e = 0; e < 8; ++e) { const unsigned long long m0 = __ballot(e0 == e), m1 = __ballot(e1 == e); const int base = tt[16 + e] + tt[8 + e];
            if (e0 == e) { const int pos = base + __popcll(m0 & lt); rowtok[pos] = m; roww[pos] = selW[i * 2]; tokpos[m * 2] = pos; }
            if (e1 == e) { const int pos = base + __popcll(m0) + __popcll(m1 & lt); rowtok[pos] = m; roww[pos] = selW[i * 2 + 1]; tokpos[m * 2 + 1] = pos; } } }
    if (F.bid < 8 && F.tid >= 64 && F.tid < 320) { const int e = F.bid, r = tt[e] + (F.tid - 64); if (r < tt[24 + e] * 256) { rowtok[tt[16 + e] + r] = 0; roww[tt[16 + e] + r] = 0.f; } }
}
__device__ __forceinline__ void t_conv(Frame& F, bf16* BB, const bf16* UC, const float* cw, int rank, int nranks) {
    if (rank < 0) return;
    const int gt = rank * 512 + F.tid, NT = nranks * 512, c8 = (gt & 127) * 8;
    f32x4 w[3][2];
#pragma unroll
    for (int k = 0; k < 3; ++k) { w[k][0] = *(const f32x4*)(cw + k * D + c8); w[k][1] = *(const f32x4*)(cw + k * D + c8 + 4); }
    for (int idx = gt; idx < M * 128; idx += 2 * NT) {
        v4u ld[2][4]; bool ok[2];
#pragma unroll
        for (int q = 0; q < 2; ++q) { const int id2 = idx + q * NT; ok[q] = id2 < M * 128; const int m = (ok[q] ? id2 : idx) >> 7, tpos = m & (SEQ - 1); const size_t off = (size_t)m * D + c8;
            ld[q][0] = *(const v4u*)(UC + off); ld[q][1] = *(const v4u*)(UC + off - (tpos >= 1 ? D : 0)); ld[q][2] = *(const v4u*)(UC + off - (tpos >= 2 ? 2 * D : 0)); ld[q][3] = *(const v4u*)(BB + off); }
#pragma unroll
        for (int q = 0; q < 2; ++q) { const int id2 = idx + q * NT; if (!ok[q]) continue; const int m = id2 >> 7, tpos = m & (SEQ - 1); const size_t off = (size_t)m * D + c8;
            f32x4 a0, a1, x0, x1; unpack8(ld[q][0], x0, x1); a0 = w[2][0] * x0; a1 = w[2][1] * x1;
            unpack8(ld[q][1], x0, x1); if (tpos >= 1) { a0 += w[1][0] * x0; a1 += w[1][1] * x1; }
            unpack8(ld[q][2], x0, x1); if (tpos >= 2) { a0 += w[0][0] * x0; a1 += w[0][1] * x1; }
            unpack8(ld[q][3], x0, x1);
            *(v4u*)(BB + off) = pack8(a0 * x0, a1 * x1); }
    }
}
__device__ __forceinline__ void t_carry4(Frame& F, int l, int pm, int g, const float* SL, bf16* UB) {
    LAS float* sl = (LAS float*)F.lds;
#pragma unroll
    for (int j = 0; j < 16; ++j) { const int i4 = F.tid + 512 * j, ck = i4 >> 5, q = i4 & 31;
        *(LAS f32x4*)(sl + i4 * 4) = *(const f32x4*)(SL + ((size_t)(pm * 256 + ck) * NG + g) * 128 + 4 * q); }
    __syncthreads();
    if (F.wave < 4) { const int n = F.lane, bb = F.wave; const f32x2 a = ((const f32x2*)(F.ws + WS_AT))[(l * NG + g) * 64 + n]; float sr = 0.f, si = 0.f;
        for (int k = 0; k < 64; ++k) { const int ck = bb * 64 + k; bf16* dst = UB + ((size_t)(pm * 256 + ck) * NG + g) * KY + 512;
            const unsigned pr = cvt_pk_bf16(sr, si); dst[n] = (bf16)(pr & 0xffffu); dst[64 + n] = (bf16)(pr >> 16);
            const float lr = sl[ck * 128 + n], li = sl[ck * 128 + 64 + n]; const float nr = a.x * sr - a.y * si + lr, ni = a.x * si + a.y * sr + li; sr = nr; si = ni; } }
    __syncthreads();
}
template <int MODE> __device__ __forceinline__ void t_combine_final(Frame& F, const bf16* XB, float* OUT, const bf16* O, const bf16* P, const float* gvec, int rank, int nranks) {
    if (rank < 0) return;
    const int gw = rank * 8 + F.wave, NGW = nranks * 8; const int* tokpos = (const int*)(F.ws + WS_TOKPOS);
    f32x4 g[4];
#pragma unroll
    for (int j = 0; j < 4; ++j) g[j] = ((const f32x4*)gvec)[F.lane + 64 * j];
    for (int m = gw; m < M; m += NGW) {
        const int p0 = tokpos[2 * m], p1 = tokpos[2 * m + 1]; const bool late = (p0 >= 32768) || (p1 >= 32768);
        if (late != (MODE == 1)) continue;
        f32x4* xr = (f32x4*)(OUT + (size_t)m * D) + F.lane; const v2u* xb = (const v2u*)(XB + (size_t)m * D) + F.lane;
        f32x4 v[4]; float s = 0.f;
#pragma unroll
        for (int j = 0; j < 4; ++j) { const v2u c = xb[64 * j]; v[j] = (f32x4){bf_lo(c.x), bf_hi(c.x), bf_lo(c.y), bf_hi(c.y)}; }
#pragma unroll
        for (int sl = 0; sl < 2; ++sl) { const int p = sl ? p1 : p0;
            if (MODE == 1 && p >= 32768) { const v2u* q0 = (const v2u*)(P + (size_t)(p - 32768) * D) + F.lane; const v2u* q1 = q0 + (size_t)2048 * D / 4;
#pragma unroll
                for (int j = 0; j < 4; ++j) { const v2u a = q0[64 * j], b = q1[64 * j]; v[j] += (f32x4){bf_lo(a.x), bf_hi(a.x), bf_lo(a.y), bf_hi(a.y)} + (f32x4){bf_lo(b.x), bf_hi(b.x), bf_lo(b.y), bf_hi(b.y)}; } }
            else { const v2u* o = (const v2u*)(O + (size_t)p * D) + F.lane;
#pragma unroll
                for (int j = 0; j < 4; ++j) { const v2u a = o[64 * j]; v[j] += (f32x4){bf_lo(a.x), bf_hi(a.x), bf_lo(a.y), bf_hi(a.y)}; } } }
#pragma unroll
        for (int j = 0; j < 4; ++j) s += (v[j][0] * v[j][0] + v[j][1] * v[j][1]) + (v[j][2] * v[j][2] + v[j][3] * v[j][3]);
        const float rstd = 1.0f / sqrtf(wave_sum(s) * (1.0f / D) + RMS_EPS);
#pragma unroll
        for (int j = 0; j < 4; ++j) xr[64 * j] = v[j] * rstd * g[j];
    }
}

#ifndef PHMASK
#define PHMASK 0xFFFFFFFFu
#endif
#define EN(k) ((PHMASK >> (k)) & 1u)
#ifndef DUPMASK
#define DUPMASK 0u
#endif
#define REP(k) for (int rep_ = 0; rep_ < 1 + (int)((DUPMASK >> (k)) & 1u); ++rep_)
#define IN(p) (lo <= (p) && (p) < hi)
#ifndef PROBE_A
#define PROBE_A (-2)
#define PROBE_B (-2)
#define PROBE_MULT 0
#endif
#define PSTAMP(p) do { if ((PROBE_A) == (p) || (PROBE_B) == (p)) { if (threadIdx.x == 0) { const unsigned long long t_ = __builtin_amdgcn_s_memrealtime(); volatile LAS unsigned* m_ = (volatile LAS unsigned*)((LAS unsigned char*)lds_raw + T_MISC); \
    if ((PROBE_A) == (p)) { m_[16] = (unsigned)t_; m_[17] = (unsigned)(t_ >> 32); } if ((PROBE_B) == (p)) { m_[18] = (unsigned)t_; m_[19] = (unsigned)(t_ >> 32); } } } } while (0)
#define SEAM(p) do { if (multi && (p) + 1 < hi) xcd_barrier(bar); PSTAMP(p); } while (0)
#define RING ((LAS unsigned char*)lds_raw)
template <int L> __device__ __forceinline__ void layer_phases(const int lo0, const int hi0, const bool multi, const XcdBarrier& bar, unsigned char* lds_raw) {
    constexpr int l = L;
    int lo = lo0, hi = hi0, G = gridDim.x, cidx = blockIdx.x; asm volatile("" : "+s"(lo), "+s"(hi), "+s"(G), "+s"(cidx));
    {
        const int pb = 1 + 16 * l;
        if (IN(pb + 1) && EN(2)) REP(2) {
            unsigned char* ws = KWS;
            SchedPlain S; S.o.init(M / 256, PW / 256, G, cidx); S.A = (const char*)(ws + WS_XB); S.B = (const char*)(ws + WS_WIN) + (size_t)l * PW * D * 2; S.tA = (size_t)256 * D * 2; S.tB = (size_t)256 * D * 2;
            EpiProj E{(bf16*)(ws + WS_BB), (bf16*)(ws + WS_UC), (bf16*)(ws + WS_UB), (bf16*)(ws + WS_GC), (bf16*)(ws + WS_GS), RING, (const float*)(ws + WS_SSQ)};
            { MKFRAME(F); prep_rstd(F, S.o, (const float*)(ws + WS_SSQ)); prep_bias(F, KIN(3) + (size_t)l * PW); }
            pg8::gemm_phase<EpiProj, SchedPlain, false, true>(RING, D * 2, D * 2, D * 2, S, E);
            { int pm_, pn_; if (!S.o.tile(5, pm_, pn_)) { MKFRAME(F); __syncthreads(); for (int job = cidx - 128; job >= 0 && job < NG * 4; job += 128) p0_ssm_job(F, l, job >> 2, job & 3);
                if (G == 256 && cidx >= 128) tr_window(F, l, 0, cidx - 128); } }
            SEAM(pb + 1);
        }
        if (IN(pb + 2) && EN(3)) REP(3) {
            unsigned char* ws = KWS;
            { SchedSsmS S; S.o.init(2, NG, G, cidx); S.UB = (const char*)(ws + WS_UB); S.BTS = (const char*)(ws + WS_BTS) + (size_t)l * NG * 128 * 512 * 2;
              EpiSloc E{(float*)(ws + WS_HN + 16 * MiB)};
              pg8::gemm_phase<EpiSloc, SchedSsmS, false, true>(RING, 512 * 2, NG * KY * 2, 512 * 2, S, E);
              { int pm_, g_; if (S.o.tile(0, pm_, g_)) { MKFRAME(F); t_carry4(F, l, pm_, g_, (const float*)(F.ws + WS_HN + 16 * MiB), (bf16*)(F.ws + WS_UB)); } } }
            { MKFRAME(F); t_conv(F, (bf16*)(F.ws + WS_BB), (const bf16*)(F.ws + WS_UC), KIN(4) + (size_t)l * 3 * D, G == 256 ? cidx - 64 : cidx, G == 256 ? 192 : G); }
            SEAM(pb + 2);
        }
        if (IN(pb + 4) && EN(5)) REP(5) {
            { unsigned char* ws = KWS;
              SchedSsmY S; S.o.init(2, 2 * NG, G, cidx); S.UB = (const char*)(ws + WS_UB); S.BTY = (const char*)(ws + WS_BTY) + (size_t)l * NG * 512 * KY * 2;
              EpiY E{(bf16*)(ws + WS_HN), (const bf16*)(ws + WS_UB), KIN(13) + (size_t)l * DSSM};
              pg8::gemm_phase<EpiY, SchedSsmY, false, true>(RING, KY * 2, NG * KY * 2, KY * 2, S, E); }
            { unsigned char* ws = KWS;
              SchedPlain S; S.o.init(M / 256, D / 256, G, cidx); S.A = (const char*)(ws + WS_BB); S.B = (const char*)(ws + WS_WCO) + (size_t)l * D * D * 2; S.tA = (size_t)256 * D * 2; S.tB = (size_t)256 * D * 2;
              EpiConvOut E{(bf16*)(ws + WS_GC)};
              pg8::gemm_phase<EpiConvOut, SchedPlain, false, true>(RING, D * 2, D * 2, D * 2, S, E); }
            if (G == 256 && cidx >= 128) { MKFRAME(F); __syncthreads(); tr_window(F, l, 1, cidx - 128); }
            SEAM(pb + 4);
        }
        if (IN(pb + 5) && EN(6)) REP(6) {
            unsigned char* ws = KWS;
            SchedPlain S; S.o.init(M / 256, 2048 / 256, G, cidx); S.A = (const char*)(ws + WS_HN); S.B = (const char*)(ws + WS_WGLU) + (size_t)l * 2048 * DSSM * 2; S.tA = (size_t)256 * DSSM * 2; S.tB = (size_t)256 * DSSM * 2;
            EpiGlu E{(bf16*)(ws + WS_GC), (const bf16*)(ws + WS_GS)};
            pg8::gemm_phase<EpiGlu, SchedPlain, false, true>(RING, DSSM * 2, DSSM * 2, DSSM * 2, S, E);
            SEAM(pb + 5);
        }
        if (IN(pb + 6) && EN(7)) REP(7) {
            unsigned char* ws = KWS;
            SchedPlain S; S.o.init(M / 256, D / 256, G, cidx); S.A = (const char*)(ws + WS_GC); S.B = (const char*)(ws + WS_WO) + (size_t)l * D * D * 2; S.tA = (size_t)256 * D * 2; S.tB = (size_t)256 * D * 2;
            EpiRes E{(bf16*)(ws + WS_XB), (float*)(ws + WS_SSQ), l == 0 ? ws + WS_XB8 : nullptr, 1.0f};
            pg8::gemm_phase<EpiRes, SchedPlain, false, true>(RING, D * 2, D * 2, D * 2, S, E);
            SEAM(pb + 6);
        }
        if (IN(pb + 7) && EN(8) && L == 1) REP(8) {
            MKFRAME(F);
            t_norm_router(F, (const bf16*)(F.ws + WS_XB), KIN(16) + D, (bf16*)(F.ws + WS_HN), KIN(20), KIN(21));
            SEAM(pb + 7);
        }
        if constexpr (L == 0) {
            if (IN(pb + 9) && EN(10)) REP(10) {
                unsigned char* ws = KWS;
                SchedPlain S; S.o.init(M / 256, 2 * DFF / 256, G, cidx); S.A = (const char*)(ws + WS_XB8); S.B = (const char*)(ws + WS_WDGU); S.tA = (size_t)256 * D; S.tB = (size_t)256 * D;
                EpiSwiglu8d E{ws + WS_HID, (const float*)(ws + WS_SSQ), RING};
                { MKFRAME(F); prep_rstd(F, S.o, (const float*)(ws + WS_SSQ)); }
                pg8::gemm_phase<EpiSwiglu8d, SchedPlain, false, true, true>(RING, D, D, D, S, E);
                SEAM(pb + 9);
            }
            if (IN(pb + 10) && EN(11)) REP(11) {
                unsigned char* ws = KWS;
                SchedPlain S; S.o.init(M / 256, D / 256, G, cidx); S.A = (const char*)(ws + WS_HID); S.B = (const char*)(ws + WS_WDD); S.tA = (size_t)256 * DFF; S.tB = (size_t)256 * DFF;
                EpiRes E{(bf16*)(ws + WS_XB), (float*)(ws + WS_SSQ), nullptr, 1.0f / (float)(1 << (HID_SH + WD_SH))};
                pg8::gemm_phase<EpiRes, SchedPlain, false, true, true>(RING, DFF, DFF, DFF, S, E);
                SEAM(pb + 10);
            }
        } else {
            if (IN(pb + 8) && EN(9)) { MKFRAME(F); t_perm(F); SEAM(pb + 8); }
            const LAS int* pexp = (const LAS int*)(RING + T_PEXP);
            if (IN(pb + 9) && EN(12)) REP(12) {
                if (lo > pb + 8) { MKFRAME(F); build_panels(F); }
                unsigned char* ws = KWS;
                SchedMoe1 S; S.o.init(pexp[MOE_PANELS], 2 * DFF / 256, G, cidx); S.HN = (const char*)(ws + WS_HN); S.W = (const char*)(ws + WS_WMGU); S.rowtok = (const int*)(ws + WS_ROWTOK); S.pexp = pexp;
                EpiSwiglu8 E{(unsigned char*)(ws + WS_HID)};
                pg8::gemm_phase<EpiSwiglu8, SchedMoe1, true, true, true>(RING, D, D, D, S, E);
                SEAM(pb + 9);
            }
            if (IN(pb + 10) && EN(13)) REP(13) {
                if (lo > pb + 8) { MKFRAME(F); build_panels(F); }
                unsigned char* ws = KWS;
                SchedMoe2 S; S.o.init(128, D / 256, G, cidx); S.HID = (const char*)(ws + WS_HID); S.W = (const char*)(ws + WS_WMD); S.pexp = pexp;
                EpiMoeDown E{(bf16*)(ws + WS_MOEO), (const float*)(ws + WS_ROWW)};
                pg8::gemm_phase<EpiMoeDown, SchedMoe2, false, true, true>(RING, DFF, DFF, DFF, S, E);
                SEAM(pb + 10);
            }
            if (IN(pb + 11) && EN(14)) {
                if (lo > pb + 8) { MKFRAME(F); build_panels(F); }
                unsigned char* ws = KWS; const int nl = (pexp[MOE_PANELS] - 128) * 8;
                { SchedMoe2L S; S.nunits = nl; S.c = cidx; S.HID = (const char*)(ws + WS_HID); S.W = (const char*)(ws + WS_WMD); S.pexp = pexp;
                  EpiMoePart E{(bf16*)(ws + WS_HN), (const float*)(ws + WS_ROWW)};
                  pg8::gemm_phase<EpiMoePart, SchedMoe2L, false, true, true>(RING, DFF / 2, DFF, DFF, S, E); }
                { MKFRAME(F); const bool busy = cidx < nl; t_combine_final<0>(F, (const bf16*)(F.ws + WS_XB), KOUT, (const bf16*)(F.ws + WS_MOEO), (const bf16*)(F.ws + WS_HN), KIN(25), busy ? -1 : cidx - nl, G - nl); }
                SEAM(pb + 11);
            }
            if (IN(pb + 12) && EN(15)) { MKFRAME(F); t_combine_final<1>(F, (const bf16*)(F.ws + WS_XB), KOUT, (const bf16*)(F.ws + WS_MOEO), (const bf16*)(F.ws + WS_HN), KIN(25), cidx, G); }
        }
    }
}
struct Args { const float* in[26]; float* out; unsigned char* ws; int ph_lo, ph_hi; };
constexpr int N_PHASES = 1 + 32;
__global__ void __launch_bounds__(512, 2) fwd_kernel(Args args) {
    extern __shared__ __attribute__((aligned(16))) unsigned char lds_raw[];
    const int lo0 = args.ph_lo, hi0 = args.ph_hi; const bool multi = (hi0 - lo0) > 1;
    volatile LAS unsigned* MISC = (volatile LAS unsigned*)((LAS unsigned char*)lds_raw + T_MISC);
    if (threadIdx.x < 32) MISC[threadIdx.x] = 0u;
    __syncthreads();
    XcdBarrier bar; bar.bar = (unsigned*)(KWS + WS_CTL) + CW_BAR; bar.x = 0; bar.st = MISC + 8;
    if (multi) bar = xcd_barrier_post((unsigned*)(KWS + WS_CTL) + CW_BAR, MISC + 8);
    int lo = lo0, hi = hi0, G = gridDim.x, cidx = blockIdx.x;
    PSTAMP(-1);

    if (IN(0) && EN(0)) REP(0) {
        MKFRAME(F); unsigned char* ws = F.ws;
        p0_transposes(F);
        t_xcvt(F, KIN(0), (bf16*)(ws + WS_XB), (float*)(ws + WS_SSQ));
        SEAM(0);
    }
    layer_phases<0>(lo0, hi0, multi, bar, lds_raw);
    layer_phases<1>(lo0, hi0, multi, bar, lds_raw);
    PSTAMP(99);
    if (PROBE_MULT > 0 && blockIdx.x == 0 && threadIdx.x == 0) { volatile LAS unsigned* m_ = (volatile LAS unsigned*)((LAS unsigned char*)lds_raw + T_MISC);
        const unsigned long long a_ = ((unsigned long long)m_[17] << 32) | m_[16], b_ = ((unsigned long long)m_[19] << 32) | m_[18], e_ = __builtin_amdgcn_s_memrealtime();
        unsigned long long d_ = (b_ - a_) * (unsigned long long)PROBE_MULT; if (d_ > 400000ull) d_ = 400000ull;
        while (__builtin_amdgcn_s_memrealtime() - e_ < d_) __builtin_amdgcn_s_sleep(8); }
#undef IN
#undef REP
#undef EN
#undef SEAM
#undef RING
}

extern "C" void kernel_launch(void* const* d_in, const int* in_sizes, int n_in, void* d_out, int out_size, void* d_ws, size_t ws_size, hipStream_t stream) {
    static int grid = 0;
    if (grid == 0) {
        if (n_in != 26 || in_sizes[0] != M * D || out_size != M * D || ws_size < WS_END) { fprintf(stderr, "kernel_launch: unexpected shapes / workspace (%zu < %zu)\n", ws_size, (size_t)WS_END); grid = -1; return; }
        int dev = 0, cus = 0;
        if (hipGetDevice(&dev) != hipSuccess || hipDeviceGetAttribute(&cus, hipDeviceAttributeMultiprocessorCount, dev) != hipSuccess) { grid = -1; return; }
        if (hipFuncSetAttribute((const void*)fwd_kernel, hipFuncAttributeMaxDynamicSharedMemorySize, LDS_BYTES) != hipSuccess) { grid = -1; return; }
        (void)hipGetLastError();
        grid = 256;
        if (cus < 256) { fprintf(stderr, "kernel_launch: needs 256 CUs, device has %d\n", cus); grid = -1; return; }
    }
    if (grid < 0) return;
    Args a{};
    for (int i = 0; i < 26; ++i) a.in[i] = (const float*)d_in[i];
    a.out = (float*)d_out; a.ws = (unsigned char*)d_ws;
#if MK_PER_PHASE
    static const int phases[] = {0, 2, 3, 5, 6, 7, 10, 11, 18, 19, 21, 22, 23, 24, 25, 26, 27, 28, 29};
    for (int p : phases) {
        if (p == 1) continue;
        a.ph_lo = p; a.ph_hi = p + 1;
        hipLaunchKernelGGL(fwd_kernel, dim3(grid), dim3(512), LDS_BYTES, stream, a);
    }
#else
    (void)hipMemsetAsync((char*)d_ws + WS_CTL, 0, CTL_ZERO_BYTES, stream);
    a.ph_lo = 0; a.ph_hi = N_PHASES;
    hipLaunchKernelGGL(fwd_kernel, dim3(grid), dim3(512), LDS_BYTES, stream, a);
#endif
}
```
